# Optimizing an MI355X kernel written in HIP

```python
import jax, jax.numpy as jnp
from jax import lax
import numpy as np

D_MODEL = 1024
BATCH = 32
SEQ = 256
DEPTH = 2
DEC_BATCH = 4
DEC_SEQ = 4096
PAST_LEN = 512

GRID_W = 64
POOL_WIDTH = 256
POOL_GROUPS = 4
POOL_WINDOWS = (2, 4, 8, 16)
POOL_GROUP_DIM = POOL_WIDTH // POOL_GROUPS
CONV_WIDTH = 256
CONV_TAPS = 31
N_HEADS = 8
N_KV_HEADS = 2
HEAD_DIM = 64
Q_GROUP = N_HEADS // N_KV_HEADS
ATTN_WIDTH = N_HEADS * HEAD_DIM
KV_WIDTH = N_KV_HEADS * HEAD_DIM
MIX_WIDTH = POOL_WIDTH + CONV_WIDTH + ATTN_WIDTH
ATTN_OFFSET = POOL_WIDTH + 2 * CONV_WIDTH
IN_WIDTH = ATTN_OFFSET + ATTN_WIDTH + 2 * KV_WIDTH
WINDOW = 128
BLOCK = 128
D_FF = 2816
N_MOD = 9
ROPE_THETA = 10000.0
EPS = 1e-6
NEG_INF = -1e30

kernel_name = 'hymba_pool_conv_swa_macaron_dit_step'


def _rms(x, g):
    xf = x.astype(jnp.float32)
    y = xf * lax.rsqrt(jnp.mean(xf * xf, axis=-1, keepdims=True) + EPS)
    return (y * g.astype(jnp.float32)).astype(x.dtype)


def _swiglu(h, wi, wo):
    gate, up = jnp.split(h @ wi, 2, axis=-1)
    return (jax.nn.silu(gate) * up) @ wo


def _modulations(cond, w, b):
    m = jax.nn.silu(cond) @ w + b
    return jnp.split(m[:, None, :], N_MOD, axis=-1)


def _pool_mixer(u, pool_w, pool_scale):
    n = u.shape[1]
    uf = u.astype(jnp.float32)
    cs = jnp.pad(jnp.cumsum(uf, axis=1), ((0, 0), (1, 0), (0, 0)))
    t = jnp.arange(n)
    outs = []
    for j, w in enumerate(POOL_WINDOWS):
        lo = jnp.clip(t - w // 2, 0, n)
        hi = jnp.clip(t + w // 2, 0, n)
        sl = slice(j * POOL_GROUP_DIM, (j + 1) * POOL_GROUP_DIM)
        csj = cs[..., sl]
        mean = (csj[:, hi] - csj[:, lo]) / (hi - lo).astype(jnp.float32)[None, :, None]
        pooled = (mean - uf[..., sl]).astype(u.dtype)
        outs.append(pooled @ pool_w[j])
    return jnp.concatenate(outs, axis=-1) * pool_scale


def _conv_mixer(g, dw, db, norm_g, pw):
    glu = g[..., :CONV_WIDTH] * jax.nn.sigmoid(g[..., CONV_WIDTH:])
    y = lax.conv_general_dilated(
        glu, dw[:, None, :].astype(glu.dtype), window_strides=(1,),
        padding=[(CONV_TAPS // 2, CONV_TAPS // 2)],
        dimension_numbers=('NWC', 'WIO', 'NWC'), feature_group_count=CONV_WIDTH) + db
    return jax.nn.silu(_rms(y, norm_g)) @ pw


def _qkv(u, q_g, k_g):
    b, n, _ = u.shape
    q = u[..., :ATTN_WIDTH].reshape(b, n, N_HEADS, HEAD_DIM)
    k = u[..., ATTN_WIDTH:ATTN_WIDTH + KV_WIDTH].reshape(b, n, N_KV_HEADS, HEAD_DIM)
    v = u[..., ATTN_WIDTH + KV_WIDTH:].reshape(b, n, N_KV_HEADS, HEAD_DIM)
    return _rms(q, q_g), _rms(k, k_g), v


def _rope_2d(x, n):
    rows = n // GRID_W
    row = jnp.repeat(jnp.arange(rows), GRID_W).astype(jnp.float32)
    col = jnp.tile(jnp.arange(GRID_W), rows).astype(jnp.float32)
    half = HEAD_DIM // 2
    inv = ROPE_THETA ** (-jnp.arange(0, half, 2, dtype=jnp.float32) / half)

    def rot(xa, pos):
        ang = pos[:, None] * inv[None, :]
        cos = jnp.cos(ang)[None, :, None, :]
        sin = jnp.sin(ang)[None, :, None, :]
        x1, x2 = xa[..., :half // 2], xa[..., half // 2:]
        return jnp.concatenate([x1 * cos - x2 * sin, x2 * cos + x1 * sin], axis=-1)

    xf = x.astype(jnp.float32)
    return jnp.concatenate([rot(xf[..., :half], row), rot(xf[..., half:], col)], axis=-1).astype(x.dtype)


def _softmax_with_sink(s, sink):
    b, _, _, nq, _ = s.shape
    sk = jnp.broadcast_to(sink.astype(jnp.float32).reshape(N_KV_HEADS, Q_GROUP)[None, :, :, None, None],
                          (b, N_KV_HEADS, Q_GROUP, nq, 1))
    p = jax.nn.softmax(jnp.concatenate([s, sk], axis=-1), axis=-1)
    return p[..., :-1]


def _context_attention(q, k, v, sink):
    b, n = q.shape[:2]
    nb = n // BLOCK
    qb = jnp.moveaxis(q.reshape(b, nb, BLOCK, N_KV_HEADS, Q_GROUP, HEAD_DIM), 1, 0)
    scale = HEAD_DIM ** -0.5

    def one(qi):
        s = jnp.einsum('bqkgd,bskd->bkgqs', qi, k).astype(jnp.float32) * scale
        p = _softmax_with_sink(s, sink).astype(v.dtype)
        return jnp.einsum('bkgqs,bskd->bqkgd', p, v)

    o = lax.map(one, qb)
    return jnp.moveaxis(o, 0, 1).reshape(b, n, ATTN_WIDTH)


def _latent_attention(q, k, v, kc, vc, sink):
    b, n = q.shape[:2]
    nb = n // BLOCK
    span = BLOCK + 2 * WINDOW
    qb = jnp.moveaxis(q.reshape(b, nb, BLOCK, N_KV_HEADS, Q_GROUP, HEAD_DIM), 1, 0)
    kp = jnp.pad(k, ((0, 0), (WINDOW, WINDOW), (0, 0), (0, 0)))
    vp = jnp.pad(v, ((0, 0), (WINDOW, WINDOW), (0, 0), (0, 0)))
    scale = HEAD_DIM ** -0.5
    offs_q = jnp.arange(BLOCK)
    offs_k = jnp.arange(span)

    def one(args):
        i, qi = args
        start = i * BLOCK
        kw = lax.dynamic_slice_in_dim(kp, start, span, axis=1)
        vw = lax.dynamic_slice_in_dim(vp, start, span, axis=1)
        qpos = start + offs_q
        kpos = start - WINDOW + offs_k
        valid = ((jnp.abs(qpos[:, None] - kpos[None, :]) <= WINDOW)
                 & (kpos >= 0)[None, :] & (kpos < n)[None, :])
        s_w = jnp.einsum('bqkgd,bskd->bkgqs', qi, kw).astype(jnp.float32) * scale
        s_w = jnp.where(valid, s_w, NEG_INF)
        s_c = jnp.einsum('bqkgd,bskd->bkgqs', qi, kc).astype(jnp.float32) * scale
        p = _softmax_with_sink(jnp.concatenate([s_w, s_c], axis=-1), sink).astype(v.dtype)
        return (jnp.einsum('bkgqs,bskd->bqkgd', p[..., :span], vw)
                + jnp.einsum('bkgqs,bskd->bqkgd', p[..., span:], vc))

    o = lax.map(one, (jnp.arange(nb), qb))
    return jnp.moveaxis(o, 0, 1).reshape(b, n, ATTN_WIDTH)


def _layer(x, cond, p, cache_k=None, cache_v=None):
    sh1, sc1, g1, sh2, sc2, g2, sh3, sc3, g3 = _modulations(cond, p['mod_w'], p['mod_b'])
    h = _rms(x, p['norm_g'][0]) * (1.0 + sc1) + sh1
    x = x + 0.5 * g1 * _swiglu(h, p['ffn1_wi'], p['ffn1_wo'])
    h = _rms(x, p['norm_g'][1]) * (1.0 + sc2) + sh2
    u = h @ p['w_in']
    o_pool = _pool_mixer(u[..., :POOL_WIDTH], p['pool_w'], p['pool_scale'])
    o_conv = _conv_mixer(u[..., POOL_WIDTH:ATTN_OFFSET], p['conv_dw'], p['conv_b'],
                         p['conv_norm_g'], p['conv_pw'])
    q, k, v = _qkv(u[..., ATTN_OFFSET:], p['q_norm_g'], p['k_norm_g'])
    if cache_k is None:
        o_attn = _context_attention(q, k, v, p['sink'])
        new_kv = (k, v)
    else:
        n = x.shape[1]
        o_attn = _latent_attention(_rope_2d(q, n), _rope_2d(k, n), v, cache_k, cache_v, p['sink'])
        new_kv = None
    x = x + g2 * (jnp.concatenate([o_pool, o_conv, o_attn], axis=-1) @ p['w_out'])
    h = _rms(x, p['norm_g'][2]) * (1.0 + sc3) + sh3
    x = x + 0.5 * g3 * _swiglu(h, p['ffn2_wi'], p['ffn2_wo'])
    return x, new_kv


def setup_inputs(seed: int = 0) -> dict:
    key = jax.random.key(seed)
    ks = jax.random.split(key, 26)
    D = D_MODEL

    def nrm(k, shape, s):
        return jax.random.normal(k, shape, jnp.float32) * s

    cache_shape = (DEC_BATCH, DEPTH, PAST_LEN, N_KV_HEADS, HEAD_DIM)
    return {
        'x_prompt': nrm(ks[0], (BATCH, SEQ, D), 1.0),
        'x_sample': nrm(ks[1], (DEC_BATCH, DEC_SEQ, D), 1.0),
        'cache_k': nrm(ks[2], cache_shape, 1.0),
        'cache_v': nrm(ks[3], cache_shape, 1.0),
        'c': nrm(ks[4], (DEC_BATCH, D), 1.0),
        'c_ctx': nrm(ks[5], (D,), 1.0),
        'mod_w': nrm(ks[6], (DEPTH, D, N_MOD * D), 0.5 * D ** -0.5),
        'mod_b': nrm(ks[7], (DEPTH, N_MOD * D), 0.02),
        'norm_g': 1.0 + nrm(ks[8], (DEPTH, 3, D), 0.02),
        'ffn1_wi': nrm(ks[9], (DEPTH, D, 2 * D_FF), D ** -0.5),
        'ffn1_wo': nrm(ks[10], (DEPTH, D_FF, D), D_FF ** -0.5),
        'ffn2_wi': nrm(ks[11], (DEPTH, D, 2 * D_FF), D ** -0.5),
        'ffn2_wo': nrm(ks[12], (DEPTH, D_FF, D), D_FF ** -0.5),
        'w_in': nrm(ks[13], (DEPTH, D, IN_WIDTH), D ** -0.5),
        'w_out': nrm(ks[14], (DEPTH, MIX_WIDTH, D), MIX_WIDTH ** -0.5),
        'pool_w': nrm(ks[15], (DEPTH, POOL_GROUPS, POOL_GROUP_DIM, POOL_GROUP_DIM), POOL_GROUP_DIM ** -0.5),
        'pool_scale': 1.0 + nrm(ks[16], (DEPTH, POOL_WIDTH), 0.1),
        'conv_dw': nrm(ks[17], (DEPTH, CONV_TAPS, CONV_WIDTH), CONV_TAPS ** -0.5),
        'conv_b': nrm(ks[18], (DEPTH, CONV_WIDTH), 0.02),
        'conv_norm_g': 1.0 + nrm(ks[19], (DEPTH, CONV_WIDTH), 0.02),
        'conv_pw': nrm(ks[20], (DEPTH, CONV_WIDTH, CONV_WIDTH), CONV_WIDTH ** -0.5),
        'q_norm_g': 1.0 + nrm(ks[21], (DEPTH, HEAD_DIM), 0.02),
        'k_norm_g': 1.0 + nrm(ks[22], (DEPTH, HEAD_DIM), 0.02),
        'sink': nrm(ks[23], (DEPTH, N_HEADS), 0.5),
    }


def reference(x_prompt, x_sample, cache_k, cache_v, c, c_ctx, mod_w, mod_b, norm_g,
              ffn1_wi, ffn1_wo, ffn2_wi, ffn2_wo, w_in, w_out, pool_w, pool_scale,
              conv_dw, conv_b, conv_norm_g, conv_pw, q_norm_g, k_norm_g, sink):
    y_prompt = x_prompt
    y_sample = x_sample
    ks, vs = [], []
    for l in range(DEPTH):
        p = {
            'mod_w': mod_w[l], 'mod_b': mod_b[l], 'norm_g': norm_g[l],
            'ffn1_wi': ffn1_wi[l], 'ffn1_wo': ffn1_wo[l],
            'ffn2_wi': ffn2_wi[l], 'ffn2_wo': ffn2_wo[l],
            'w_in': w_in[l], 'w_out': w_out[l],
            'pool_w': pool_w[l], 'pool_scale': pool_scale[l],
            'conv_dw': conv_dw[l], 'conv_b': conv_b[l], 'conv_norm_g': conv_norm_g[l],
            'conv_pw': conv_pw[l], 'q_norm_g': q_norm_g[l], 'k_norm_g': k_norm_g[l],
            'sink': sink[l],
        }
        y_prompt, (k_l, v_l) = _layer(y_prompt, c_ctx[None, :], p)
        ks.append(k_l)
        vs.append(v_l)
        y_sample, _ = _layer(y_sample, c, p, cache_k[:, l], cache_v[:, l])
    new_cache_k = jnp.stack(ks, axis=1)
    new_cache_v = jnp.stack(vs, axis=1)
    return (y_prompt, y_sample, new_cache_k, new_cache_v)
```

```cpp
#include <hip/hip_runtime.h>
#include <hip/hip_cooperative_groups.h>
#include <cstdio>
#include <cstdint>
namespace cg = cooperative_groups;
namespace pg8 {
#define PG8_LAS __attribute__((address_space(3)))
typedef unsigned short bf16_t;
typedef short bf16x8 __attribute__((ext_vector_type(8)));
typedef float f32x4 __attribute__((ext_vector_type(4)));
typedef unsigned u32x4 __attribute__((ext_vector_type(4)));
constexpr int BM = 256, BK = 64, HALF = 128, HTB = HALF * BK * 2  , STAGE_BYTES = 8 * HTB, NXCD = 8, WGM = 8;

__host__ __device__ __forceinline__ int lds_byte(int r, int c) { const int st = (r >> 4) * 2 + (c >> 5), rr = r & 15, cc = c & 31, ob = rr * 64 + cc * 2; return st * 1024 + (ob ^ (((ob >> 9) & 1) << 5)); }
__host__ __device__ __forceinline__ void stage_rc(int b, int& R, int& C) { const int st = b / 1024, sb = b % 1024, swz = sb ^ (((sb >> 9) & 1) << 5); R = (st >> 1) * 16 + swz / 64; C = (st & 1) * 32 + (swz % 64) / 2; }
__host__ __device__ __forceinline__ int perm32(int rho) { const int n = rho >> 4, i = rho & 15; return 8 * (i >> 2) + 4 * n + (i & 3); }

struct Unit { int pm, pn; };
struct Gemm { const bf16_t* A; const bf16_t* Bt; int M, N, K; int ablk, bblk; };

struct StaticOrder {
    int nM, nN, nwg, G, c, wgm;
    __host__ __device__ void init(int M, int N, int G_, int c_, int bm = BM) { nM = M / bm; nN = N / BM; nwg = nM * nN; G = G_; c = c_; wgm = WGM; }
    __host__ __device__ bool next(int i, Unit& u) const {
        const long L = (long)i * G + c; if (L >= nwg) return false;
        int wgid = (int)L; { const int q = nwg / NXCD, r = nwg % NXCD, xcd = wgid % NXCD, off = wgid / NXCD; wgid = (xcd < r ? xcd * (q + 1) : r * (q + 1) + (xcd - r) * q) + off; }
        const int nig = wgm * nN, gid = wgid / nig, fm = gid * wgm, gsz = (nM - fm) < wgm ? (nM - fm) : wgm;
        u.pm = fm + ((wgid % nig) % gsz); u.pn = (wgid % nig) / gsz; return true;
    }
    __device__ __forceinline__ void a_ready(const Unit&) const {}
    __device__ __forceinline__ void done(const Unit&) const {}
};

__device__ __forceinline__ unsigned cvt_pk_bf16(float lo, float hi) { unsigned r; asm volatile("v_cvt_pk_bf16_f32 %0, %1, %2" : "=v"(r) : "v"(lo), "v"(hi)); return r; }
template <class Epi, class Sched, bool ALIGN_EPI = false, bool SP2 = false, bool HALFM = false>
__device__ __forceinline__ void gemm_phase(PG8_LAS unsigned char* lds, const Gemm g, const Sched& S, const Epi& E) {
    int tid_ = threadIdx.x; asm volatile("" : "+v"(tid_));
    const int tid = tid_, wid = __builtin_amdgcn_readfirstlane(tid >> 6), lane = tid & 63, wr = wid >> 2, wc = wid & 3, fr = lane & 15, fq = lane >> 4;
    const int K = g.K, nt = K / BK;
    unsigned voffA[2], voffB[2];
#pragma unroll
    for (int i = 0; i < 2; ++i) { int R, C; stage_rc(tid * 16 + i * 8192, R, C); const int Rb = Epi::PERM ? ((R & ~31) + perm32(R & 31)) : R;
        voffA[i] = (unsigned)(R * (g.ablk ? BK : K) + C) * 2u; voffB[i] = (unsigned)(Rb * (g.bblk ? BK : K) + C) * 2u; }
    const size_t kstepA = g.ablk ? (size_t)BM * BK * 2 : (size_t)(BK * 2), kstepB = g.bblk ? (size_t)BM * BK * 2 : (size_t)(BK * 2);
    const size_t hstepA = HALFM ? (size_t)0 : (g.ablk ? (size_t)HALF * BK * 2 : (size_t)HALF * K * 2), hstepB = g.bblk ? (size_t)HALF * BK * 2 : (size_t)HALF * K * 2;
    const size_t tstepB = (size_t)BM * K * 2, tstepA = HALFM ? tstepB / 2 : tstepB;
    const unsigned ldsw = (unsigned)wid * 1024u;
    const int aoff = lds_byte(wr * 64 + fr, fq * 8), boff = lds_byte(wc * 32 + fr, fq * 8);
#define PG8_SA(b, h) (((b) * 2 + (h)) * HTB)
#define PG8_SB(b, h) ((4 + (b) * 2 + (h)) * HTB)
#define PG8_STAGE(bufoff, gbase, voff) do { _Pragma("unroll") for (int _i = 0; _i < 2; ++_i) \
        __builtin_amdgcn_global_load_lds((const unsigned*)((const char*)(gbase) + (voff)[_i]), (PG8_LAS unsigned*)(lds + (bufoff) + ldsw + _i * 8192), 16, 0, 0); } while (0)
#define PG8_LDA(dst, b, h) do { _Pragma("unroll") for (int m = 0; m < 4; ++m) _Pragma("unroll") for (int k = 0; k < 2; ++k) dst[m][k] = *(const PG8_LAS bf16x8*)(lds + PG8_SA(b, h) + aoff + m * 2048 + k * 1024); } while (0)
#define PG8_LDB(dst, b, h) do { _Pragma("unroll") for (int n = 0; n < 2; ++n) _Pragma("unroll") for (int k = 0; k < 2; ++k) dst[n][k] = *(const PG8_LAS bf16x8*)(lds + PG8_SB(b, h) + boff + n * 2048 + k * 1024); } while (0)
#define PG8_MMA(ai, bj, At, Bt) do { __builtin_amdgcn_s_setprio(1); _Pragma("unroll") for (int m = 0; m < 4; ++m) _Pragma("unroll") for (int n = 0; n < 2; ++n) _Pragma("unroll") for (int k = 0; k < 2; ++k) \
        acc[ai][bj][m][n] = __builtin_amdgcn_mfma_f32_16x16x32_bf16(Bt[n][k], At[m][k], acc[ai][bj][m][n], 0, 0, 0); __builtin_amdgcn_s_setprio(0); } while (0)
#define PG8_WAIT_V(n) asm volatile("s_waitcnt vmcnt(" #n ")" ::: "memory")
#define PG8_WAIT_L(n) asm volatile("s_waitcnt lgkmcnt(" #n ")" ::: "memory")
#define PG8_BAR __builtin_amdgcn_s_barrier()
#define PG8_SCHED __builtin_amdgcn_sched_barrier(0)
    Unit cur, nxt; int ui = 0;
    if (!S.next(0, cur)) return;
    f32x4 acc[2][2][4][2];
#pragma unroll
    for (int a = 0; a < 2; ++a)
#pragma unroll
        for (int b = 0; b < 2; ++b)
#pragma unroll
            for (int m = 0; m < 4; ++m)
#pragma unroll
                for (int n = 0; n < 2; ++n) acc[a][b][m][n] = (f32x4){0.f, 0.f, 0.f, 0.f};
    bf16x8 At[4][2], B0[2][2], B1[2][2];
    const char* cA = (const char*)g.A + (size_t)cur.pm * tstepA; const char* cB = (const char*)g.Bt + (size_t)cur.pn * tstepB;
    S.a_ready(cur);
    if constexpr (Epi::PREFETCH) E.issue(cur, wid, wr, wc, lane);
    if constexpr (SP2) {
        PG8_STAGE(PG8_SB(0, 0), cB, voffB); PG8_STAGE(PG8_SB(0, 1), cB + hstepB, voffB); PG8_STAGE(PG8_SA(0, 0), cA, voffA); PG8_STAGE(PG8_SA(0, 1), cA + hstepA, voffA);
        if (wr == 1) PG8_BAR;
        PG8_WAIT_V(2); PG8_BAR;
        PG8_STAGE(PG8_SB(1, 0), cB + kstepB, voffB); PG8_STAGE(PG8_SA(1, 0), cA + kstepA, voffA); PG8_STAGE(PG8_SB(1, 1), cB + hstepB + kstepB, voffB);
        PG8_WAIT_V(6); PG8_BAR;
    } else {
        PG8_STAGE(PG8_SB(0, 0), cB, voffB); PG8_STAGE(PG8_SA(0, 0), cA, voffA); PG8_STAGE(PG8_SB(0, 1), cB + hstepB, voffB); PG8_STAGE(PG8_SA(0, 1), cA + hstepA, voffA);
        if (wr == 1) PG8_BAR;
        PG8_WAIT_V(4); PG8_BAR;
        PG8_STAGE(PG8_SB(1, 0), cB + kstepB, voffB); PG8_STAGE(PG8_SA(1, 0), cA + kstepA, voffA); PG8_STAGE(PG8_SB(1, 1), cB + hstepB + kstepB, voffB);
        PG8_WAIT_V(6); PG8_BAR;
    }
    for (;;) {
        const bool has_next = S.next(ui + 1, nxt);
        const char* nA = has_next ? (const char*)g.A + (size_t)nxt.pm * tstepA : cA; const char* nB = has_next ? (const char*)g.Bt + (size_t)nxt.pn * tstepB : cB;
        for (int t = 0; t < nt; t += 2) {
            const bool last = (t == nt - 2);
            const char* a1 = cA + (size_t)(t + 1) * kstepA;
            const char* a2 = last ? nA : cA + (size_t)(t + 2) * kstepA; const char* b2 = last ? nB : cB + (size_t)(t + 2) * kstepB;
            const char* a3 = a2 + kstepA; const char* b3 = b2 + kstepB;
            if (last && has_next) S.a_ready(nxt);
            if constexpr (SP2) {
            PG8_LDB(B0, 0, 0); PG8_LDB(B1, 0, 1); PG8_SCHED; PG8_LDA(At, 0, 0); PG8_STAGE(PG8_SA(1, 1), a1 + hstepA, voffA);
            PG8_WAIT_V(8); PG8_WAIT_L(0); PG8_BAR; PG8_MMA(0, 0, At, B0); PG8_MMA(0, 1, At, B1); PG8_BAR; PG8_SCHED;
            if constexpr (!HALFM) { PG8_LDA(At, 0, 1); } PG8_STAGE(PG8_SB(0, 0), b2, voffB); PG8_STAGE(PG8_SB(0, 1), b2 + hstepB, voffB); PG8_STAGE(PG8_SA(0, 0), a2, voffA);
            PG8_WAIT_V(8); PG8_WAIT_L(0); PG8_BAR; if constexpr (!HALFM) { PG8_MMA(1, 0, At, B0); PG8_MMA(1, 1, At, B1); } PG8_BAR; PG8_SCHED;
            PG8_LDB(B0, 1, 0); PG8_LDB(B1, 1, 1); PG8_SCHED; PG8_LDA(At, 1, 0); PG8_STAGE(PG8_SA(0, 1), a2 + hstepA, voffA);
            PG8_WAIT_V(8); PG8_WAIT_L(0); PG8_BAR; PG8_MMA(0, 0, At, B0); PG8_MMA(0, 1, At, B1); PG8_BAR; PG8_SCHED;
            if constexpr (!HALFM) { PG8_LDA(At, 1, 1); } PG8_STAGE(PG8_SB(1, 0), b3, voffB); PG8_STAGE(PG8_SB(1, 1), b3 + hstepB, voffB); PG8_STAGE(PG8_SA(1, 0), a3, voffA);
            PG8_WAIT_V(8); PG8_WAIT_L(0); PG8_BAR; if constexpr (!HALFM) { PG8_MMA(1, 0, At, B0); PG8_MMA(1, 1, At, B1); } PG8_BAR; PG8_SCHED;
            } else {
            PG8_LDB(B0, 0, 0); PG8_SCHED; PG8_LDA(At, 0, 0); PG8_STAGE(PG8_SA(1, 1), a1 + hstepA, voffA);
            PG8_WAIT_L(8); PG8_BAR; PG8_WAIT_L(0); PG8_MMA(0, 0, At, B0); PG8_BAR; PG8_SCHED;
            PG8_LDB(B1, 0, 1); PG8_STAGE(PG8_SB(0, 0), b2, voffB);
            PG8_BAR; PG8_WAIT_L(0); PG8_MMA(0, 1, At, B1); PG8_BAR;
            PG8_LDA(At, 0, 1); PG8_STAGE(PG8_SA(0, 0), a2, voffA);
            PG8_BAR; PG8_WAIT_L(0); PG8_MMA(1, 0, At, B0); PG8_BAR; PG8_SCHED;
            PG8_STAGE(PG8_SB(0, 1), b2 + hstepB, voffB);
            PG8_WAIT_V(6); PG8_BAR; PG8_MMA(1, 1, At, B1); PG8_BAR;
            PG8_LDB(B0, 1, 0); PG8_SCHED; PG8_LDA(At, 1, 0); PG8_STAGE(PG8_SA(0, 1), a2 + hstepA, voffA);
            PG8_WAIT_L(8); PG8_BAR; PG8_WAIT_L(0); PG8_MMA(0, 0, At, B0); PG8_BAR; PG8_SCHED;
            PG8_LDB(B1, 1, 1); PG8_STAGE(PG8_SB(1, 0), b3, voffB);
            PG8_BAR; PG8_WAIT_L(0); PG8_MMA(0, 1, At, B1); PG8_BAR;
            PG8_LDA(At, 1, 1); PG8_STAGE(PG8_SA(1, 0), a3, voffA);
            PG8_BAR; PG8_WAIT_L(0); PG8_MMA(1, 0, At, B0); PG8_BAR; PG8_SCHED;
            PG8_STAGE(PG8_SB(1, 1), b3 + hstepB, voffB);
            PG8_WAIT_V(6); PG8_BAR; PG8_MMA(1, 1, At, B1); PG8_BAR;
            }
        }
        if constexpr (ALIGN_EPI) { if (wr == 0) PG8_BAR; }
        if constexpr (!Epi::AFTER_DRAIN) { E(acc, cur, wr, wc, fr, fq); S.done(cur); }
        if (!has_next) break;
#pragma unroll
        for (int a = 0; a < 2; ++a)
#pragma unroll
            for (int b = 0; b < 2; ++b)
#pragma unroll
                for (int m = 0; m < 4; ++m)
#pragma unroll
                    for (int n = 0; n < 2; ++n) acc[a][b][m][n] = (f32x4){0.f, 0.f, 0.f, 0.f};
        cur = nxt; cA = nA; cB = nB; ++ui;
        if constexpr (Epi::PREFETCH) E.issue(cur, wid, wr, wc, lane);
        if constexpr (ALIGN_EPI) { if (wr == 1) PG8_BAR; }
    }
    PG8_WAIT_V(0);
    if constexpr (!ALIGN_EPI) { if (wr == 0) PG8_BAR; }
    PG8_BAR;
    if constexpr (Epi::AFTER_DRAIN) { E.fused(acc, cur, wr, wc, fr, fq, lds, wid, lane); S.done(cur); }
#undef PG8_SA
#undef PG8_SB
#undef PG8_STAGE
#undef PG8_LDA
#undef PG8_LDB
#undef PG8_MMA
#undef PG8_WAIT_V
#undef PG8_WAIT_L
#undef PG8_BAR
#undef PG8_SCHED
}
}

#define LAS __attribute__((address_space(3)))
typedef unsigned short bf16;
typedef float f32x4 __attribute__((ext_vector_type(4)));
typedef float f32x16 __attribute__((ext_vector_type(16)));
typedef short bf16x8 __attribute__((ext_vector_type(8)));
typedef unsigned u32x4 __attribute__((ext_vector_type(4)));
typedef unsigned u32x2 __attribute__((ext_vector_type(2)));
typedef __bf16 bf16x2_t __attribute__((ext_vector_type(2)));
typedef float f32x2_t __attribute__((ext_vector_type(2)));
#define LDS_WAIT() asm volatile("s_waitcnt lgkmcnt(0)" ::: "memory")
#define LDS_BARRIER() do { asm volatile("s_waitcnt lgkmcnt(0)" ::: "memory"); __builtin_amdgcn_s_barrier(); asm volatile("" ::: "memory"); } while (0)

constexpr int DM = 1024, TC = 8192, TL = 16384, T = 24576, DFF = 2816, NIN = 1536, NMODV = 9216;
constexpr float EPS = 1e-6f, LOG2E = 1.4426950408889634f;
constexpr size_t MiB = 1u << 20;
constexpr size_t WS_ROPE = 512 * 1024, WS_CK = 1 * MiB, WS_CV = 2 * MiB, WS_W = 4 * MiB, W_LAYER = 38 * MiB;
constexpr size_t W_WI1 = 0, W_WO1 = 11 * MiB, W_WI2 = 16 * MiB + 512 * 1024, W_WO2 = 27 * MiB + 512 * 1024, W_WIN = 33 * MiB, W_WOUT = 36 * MiB;
constexpr size_t WS_H = 80 * MiB, WS_ACT = 128 * MiB, WS_UP = 128 * MiB, WS_GLU = 140 * MiB, WS_Q = 152 * MiB, WS_K = 176 * MiB, WS_V = 182 * MiB, WS_MIX = 188 * MiB, WS_BIAS = 260 * MiB, WS_GS = WS_BIAS + 512 * 1024, WS_IGS = WS_BIAS + 768 * 1024, WS_X16 = 261 * MiB, WS_END = 309 * MiB;
constexpr size_t WS_CTL = 3 * MiB, CTL_BYTES = 1 * MiB;
constexpr size_t WS_RSQ = WS_CTL + 64 * 1024, WS_MODS = WS_CTL + 640 * 1024;
constexpr int BIAS_L = 64000;
__host__ __device__ constexpr int bias_off(int kind) { return kind == 0 ? 0 : (kind == 1 ? 28160 : 35840); }
constexpr int LDS_BYTES = 131072 + 1024 + 8 * 768;
constexpr int PSLOT = 131072 + 1024;
constexpr int NTHREADS = 512;
#ifndef RESID_ALIGN
#define RESID_ALIGN true
#endif

__device__ __forceinline__ unsigned pk2(float lo, float hi) { f32x2_t v = {lo, hi}; return __builtin_bit_cast(unsigned, __builtin_convertvector(v, bf16x2_t)); }
__device__ __forceinline__ float bf2f(bf16 b) { return __builtin_bit_cast(float, (unsigned)b << 16); }
__device__ __forceinline__ float wave_sum(float v) {
#pragma unroll
    for (int o = 1; o < 64; o <<= 1) v += __shfl_xor(v, o);
    return v;
}
__device__ __forceinline__ float fast_sigmoid(float x) { return __builtin_amdgcn_rcpf(1.f + __builtin_amdgcn_exp2f(-x * LOG2E)); }
__device__ __forceinline__ int cond_of(int r) { return r < TC ? 0 : 1 + ((r - TC) >> 12); }

struct Params { const float* in[24]; float* out; unsigned char* ws; };
constexpr int PTAB = 131072;
__device__ __forceinline__ unsigned long long ldp_raw(LAS unsigned char* lds, int i) {
    asm volatile("" ::: "memory");
    const unsigned lo = *(volatile LAS unsigned*)(lds + PTAB + 8 * i), hi = *(volatile LAS unsigned*)(lds + PTAB + 8 * i + 4);
    return ((unsigned long long)(unsigned)__builtin_amdgcn_readfirstlane((int)hi) << 32) | (unsigned)__builtin_amdgcn_readfirstlane((int)lo);
}
#define GAS __attribute__((address_space(1)))
#define INP(i) ((const float*)(const GAS float*)ldp_raw(lds, (i)))
#define OUTP() ((float*)(GAS float*)ldp_raw(lds, 24))
#define WSP() ((unsigned char*)(GAS unsigned char*)ldp_raw(lds, 25))
#define XB_TMO      128
#define XB_XCNT(j)  (256  + 64 * (j))
#define XB_XSUB(j)  (1280 + 64 * (j))
#define XB_XGEN(j)  (2304 + 64 * (j))
#define XB_TOP      3328
#define XB_TOPGEN   3392
#define XCD_BAR_WORDS 3456
#define XB_SPIN_CAP (1u << 18)

__device__ __forceinline__ unsigned xb_ld(unsigned* p)              { return __hip_atomic_load(p, __ATOMIC_RELAXED, __HIP_MEMORY_SCOPE_AGENT); }
__device__ __forceinline__ unsigned xb_add(unsigned* p, unsigned v) { return __hip_atomic_fetch_add(p, v, __ATOMIC_RELAXED, __HIP_MEMORY_SCOPE_AGENT); }
__device__ __forceinline__ unsigned xb_xcc_id() { return (unsigned)__builtin_amdgcn_s_getreg((3 << 11) | 20) & 0xFu; }
#define XB_SPIN(cond, bar) do { unsigned _sp = 0; while (cond) { __builtin_amdgcn_s_sleep(1); \
    if ((++_sp & 255u) == 0u) { if (xb_ld(&(bar)[XB_TMO])) break; if (_sp > XB_SPIN_CAP) { atomicAdd(&(bar)[XB_TMO], 1u); break; } } } } while (0)

struct XcdBarrier {
    unsigned* bar; unsigned x;
    volatile LAS unsigned* st;
};

__device__ __forceinline__ XcdBarrier xcd_barrier_post(unsigned* bar, volatile LAS unsigned* st) {
    XcdBarrier b; b.bar = bar; b.x = xb_xcc_id(); b.st = st;
    if (threadIdx.x == 0) (void)xb_add(&bar[XB_XCNT(b.x)], 1u);
    return b;
}
__device__ __forceinline__ void xcd_barrier_complete(unsigned* bar, unsigned x, unsigned& nloc, unsigned& nx) {
    const unsigned G = gridDim.x * gridDim.y * gridDim.z;
    unsigned sum, cnt, mine, sp = 0u;
    for (;;) {
        sum = 0u; cnt = 0u; mine = 0u;
#pragma unroll
        for (unsigned j = 0; j < 16; ++j) { const unsigned c = xb_ld(&bar[XB_XCNT(j)]); sum += c; cnt += (c > 0u) ? 1u : 0u; mine = (j == x) ? c : mine; }
        if (sum == G) break;
        __builtin_amdgcn_s_sleep(1);
        if ((++sp & 255u) == 0u) { if (xb_ld(&bar[XB_TMO])) break; if (sp > XB_SPIN_CAP) { atomicAdd(&bar[XB_TMO], 1u); break; } }
    }
    nloc = mine > 0u ? mine : 1u; nx = cnt > 0u ? cnt : 1u;
}

__device__ __forceinline__ void xcd_barrier(const XcdBarrier& b) {
    asm volatile("s_waitcnt vmcnt(0)" ::: "memory");
    __syncthreads();
    if (threadIdx.x == 0) {
        unsigned* bar = b.bar;
        __builtin_amdgcn_s_waitcnt(0);
        unsigned nloc = b.st[0], nx = b.st[1];
        if (nloc == 0u) { xcd_barrier_complete(bar, b.x, nloc, nx); b.st[0] = nloc; b.st[1] = nx; }
        const unsigned old = xb_add(&bar[XB_XSUB(b.x)], 1u);
        const unsigned gen = old / nloc;
        if (old + 1u == (gen + 1u) * nloc) {
            __builtin_amdgcn_fence(__ATOMIC_RELEASE, "agent");
            asm volatile("s_waitcnt vmcnt(0)" ::: "memory");
            const unsigned og = xb_add(&bar[XB_TOP], 1u);
            const unsigned tg = og / nx;
            if (og + 1u == (tg + 1u) * nx) xb_add(&bar[XB_TOPGEN], 1u);
            else XB_SPIN(xb_ld(&bar[XB_TOPGEN]) == tg, bar);
            __builtin_amdgcn_fence(__ATOMIC_ACQUIRE, "agent");
            xb_add(&bar[XB_XGEN(b.x)], 1u);
            asm volatile("s_waitcnt vmcnt(0)" ::: "memory");
        } else {
            XB_SPIN(xb_ld(&bar[XB_XGEN(b.x)]) == gen, bar);
            __builtin_amdgcn_fence(__ATOMIC_ACQUIRE, "agent");
            asm volatile("s_waitcnt vmcnt(0)" ::: "memory");
        }
    }
    __syncthreads();
}

#define GRID_BAR() do { XcdBarrier b_; b_.bar = (unsigned*)(WSP() + WS_CTL); b_.x = xb_xcc_id(); b_.st = (volatile LAS unsigned*)(lds + PTAB + 256); xcd_barrier(b_); } while (0)

using pg8::Unit;
__device__ __forceinline__ void epi_issue_params(LAS unsigned char* lds, int wid, int lane, const float* rsq_rows  , const float* bias_lane  ) {
    LAS unsigned* slot = (LAS unsigned*)(lds + PSLOT + wid * 768);
    const float* r0 = rsq_rows + (lane >> 4) * 16 + (lane & 15);
    __builtin_amdgcn_global_load_lds((const unsigned*)r0, slot, 4, 0, 0);
    __builtin_amdgcn_global_load_lds((const unsigned*)(r0 + 128), slot + 64, 4, 0, 0);
    __builtin_amdgcn_global_load_lds((const unsigned*)bias_lane, slot + 128, 4, 0, 0);
}
template <bool HALF> struct EpiSwigluT {
    static constexpr int RM = HALF ? 128 : 256;
    static constexpr bool PREFETCH = true, PERM = true, AFTER_DRAIN = false;
    LAS unsigned char* lds; int st;
    __device__ __forceinline__ void issue(const Unit& u, int wid, int wr, int wc, int lane) const {
        unsigned char* ws = WSP(); const int l = st / 3, kind = st % 3, fq = lane >> 4, i = lane & 15;
        const float* rsq = (const float*)(ws + WS_RSQ) + (size_t)st * T + u.pm * RM + wr * 64;
        const float* bp = (const float*)(ws + WS_BIAS) + l * BIAS_L + bias_off(kind) + cond_of(u.pm * RM) * (2 * DFF) + u.pn * 256 + wc * 32 + 8 * fq + (i >> 3) * 128 + (i & 7);
        epi_issue_params(lds, wid, lane, rsq, bp);
    }
    __device__ __forceinline__ void operator()(const f32x4 (&acc)[2][2][4][2], const Unit& u, int wr, int wc, int fr, int fq) const {
        bf16* O = (bf16*)(WSP() + WS_ACT);
        const LAS float* slot = (const LAS float*)(lds + PSLOT + (wr * 4 + wc) * 768);
        const int row0 = u.pm * RM + wr * 64 + fr, col0 = u.pn * 128 + wc * 32 + 8 * fq;
        float rsv[8]; f32x4 bv[4];
#pragma unroll
        for (int k = 0; k < 8; ++k) rsv[k] = rsqrtf(slot[(k >> 2) * 64 + (k & 3) * 16 + fr] * (1.f / DM) + EPS);
#pragma unroll
        for (int k = 0; k < 4; ++k) bv[k] = *(const LAS f32x4*)(slot + 128 + fq * 16 + 4 * k);
#pragma unroll
        for (int ai = 0; ai < (HALF ? 1 : 2); ++ai)
#pragma unroll
            for (int m = 0; m < 4; ++m) {
                const int r = row0 + ai * 128 + m * 16;
                const float rs = rsv[ai * 4 + m];
                bf16* rowp = O + (size_t)r * DFF + col0;
                float v[8];
#pragma unroll
                for (int n = 0; n < 2; ++n)
#pragma unroll
                    for (int j = 0; j < 4; ++j) { const float g = acc[ai][0][m][n][j] * rs + bv[n][j], up = acc[ai][1][m][n][j] * rs + bv[2 + n][j]; v[4 * n + j] = g * fast_sigmoid(g) * up; }
                u32x4 w; w.x = pk2(v[0], v[1]); w.y = pk2(v[2], v[3]); w.z = pk2(v[4], v[5]); w.w = pk2(v[6], v[7]);
                *(u32x4*)rowp = w;
            }
    }
};
typedef EpiSwigluT<false> EpiSwiglu;
template <bool HALF> struct EpiResidT {
    static constexpr bool PREFETCH = false, PERM = true, AFTER_DRAIN = false;
    LAS unsigned char* lds; int st;
    __device__ __forceinline__ void operator()(const f32x4 (&acc)[2][2][4][2], const Unit& u, int wr, int wc, int fr, int fq) const {
        unsigned char* ws = WSP(); const int l = st / 3, kind = st % 3;
        constexpr int RM = HALF ? 128 : 256;
        float* Xo = OUTP(); const float* igs = (const float*)(ws + WS_IGS) + (size_t)st * 5 * DM;
        const float* gate = (const float*)(ws + WS_MODS) + (size_t)l * 5 * NMODV + (3 * kind + 2) * 1024; const float coef = (kind == 1) ? 1.f : 0.5f;
        bf16* H = (bf16*)(ws + WS_H); const float* gsn = (const float*)(ws + WS_GS) + (size_t)(st + 1) * 5 * DM; float* rsqn = (float*)(ws + WS_RSQ) + (size_t)(st + 1) * T;
        const int row0 = u.pm * RM + wr * 64 + fr, col0 = u.pn * 256 + wc * 32 + 8 * fq;
        const int cond = cond_of(u.pm * RM);
        const float* gp = gate + cond * NMODV;
        const bool last = (st == 5);
        f32x4 gv[2][2], sv[2][2], iv[2][2];
#pragma unroll
        for (int bj = 0; bj < 2; ++bj)
#pragma unroll
            for (int n = 0; n < 2; ++n) { gv[bj][n] = *(const f32x4*)(gp + col0 + bj * 128 + n * 4) * coef; sv[bj][n] = !last ? *(const f32x4*)(gsn + cond * DM + col0 + bj * 128 + n * 4) : (f32x4){0.f, 0.f, 0.f, 0.f};
                iv[bj][n] = *(const f32x4*)(igs + cond * DM + col0 + bj * 128 + n * 4); }
#pragma unroll
        for (int ai = 0; ai < (HALF ? 1 : 2); ++ai)
#pragma unroll
            for (int mp = 0; mp < 2; ++mp) {
                f32x4 xi[2][2][2];
                {
#pragma unroll
                    for (int mm = 0; mm < 2; ++mm)
#pragma unroll
                        for (int bj = 0; bj < 2; ++bj) { const u32x4 t = *(const u32x4*)(H + (size_t)(row0 + ai * 128 + (2 * mp + mm) * 16) * DM + col0 + bj * 128);
                            xi[mm][bj][0] = (f32x4){__builtin_bit_cast(float, t.x << 16), __builtin_bit_cast(float, t.x & 0xffff0000u), __builtin_bit_cast(float, t.y << 16), __builtin_bit_cast(float, t.y & 0xffff0000u)};
                            xi[mm][bj][1] = (f32x4){__builtin_bit_cast(float, t.z << 16), __builtin_bit_cast(float, t.z & 0xffff0000u), __builtin_bit_cast(float, t.w << 16), __builtin_bit_cast(float, t.w & 0xffff0000u)};
                            xi[mm][bj][0] = xi[mm][bj][0] * iv[bj][0]; xi[mm][bj][1] = xi[mm][bj][1] * iv[bj][1]; }
                }
#pragma unroll
                for (int mm = 0; mm < 2; ++mm) {
                    const int m = 2 * mp + mm, r = row0 + ai * 128 + m * 16;
                    const size_t ro = (size_t)r * DM + col0;
                    float ss = 0.f;
#pragma unroll
                    for (int bj = 0; bj < 2; ++bj) {
                        const f32x4 x0 = xi[mm][bj][0] + gv[bj][0] * acc[ai][bj][m][0], x1 = xi[mm][bj][1] + gv[bj][1] * acc[ai][bj][m][1];
                        if (last) { *(f32x4*)(Xo + ro + bj * 128) = x0; *(f32x4*)(Xo + ro + bj * 128 + 4) = x1; }
                        else {
                            ss += ((x0[0] * x0[0] + x0[1] * x0[1]) + (x0[2] * x0[2] + x0[3] * x0[3])) + ((x1[0] * x1[0] + x1[1] * x1[1]) + (x1[2] * x1[2] + x1[3] * x1[3]));
                            const f32x4 h0 = x0 * sv[bj][0], h1 = x1 * sv[bj][1];
                            u32x4 w; w.x = pk2(h0[0], h0[1]); w.y = pk2(h0[2], h0[3]); w.z = pk2(h1[0], h1[1]); w.w = pk2(h1[2], h1[3]); *(u32x4*)(H + ro + bj * 128) = w; } }
                    if (!last) { ss += __shfl_xor(ss, 16); ss += __shfl_xor(ss, 32); if (fq == 0) unsafeAtomicAdd(rsqn + r, ss); }
                }
            }
    }
};
typedef EpiResidT<false> EpiResid;
struct TailHalfOrder {
    int c, G;
    __device__ __forceinline__ bool next(int i, Unit& u) const { if (i != 0 || c >= 256) return false; const int xcd = c & 7, idx = c >> 3; u.pm = 128 + xcd * 8 + (idx & 7); u.pn = idx >> 3; return true; }
    __device__ __forceinline__ void a_ready(const Unit&) const {}
    __device__ __forceinline__ void done(const Unit&) const {}
};
template <bool HALF> struct EpiInProjT {
    static constexpr int RM = HALF ? 128 : 256;
    static constexpr bool PREFETCH = true, PERM = false, AFTER_DRAIN = false;
    LAS unsigned char* lds; int st;
    __device__ __forceinline__ void issue(const Unit& u, int wid, int wr, int wc, int lane) const {
        unsigned char* ws = WSP(); const int layer = st / 3, fq = lane >> 4, i = lane & 15;
        const float* rsq = (const float*)(ws + WS_RSQ) + (size_t)st * T + u.pm * RM + wr * 64;
        const float* bp = (const float*)(ws + WS_BIAS) + layer * BIAS_L + bias_off(1) + cond_of(u.pm * RM) * NIN + u.pn * 256 + wc * 32 + 4 * fq + (i >> 3) * 128 + ((i >> 2) & 1) * 16 + (i & 3);
        epi_issue_params(lds, wid, lane, rsq, bp);
    }
    __device__ __forceinline__ void operator()(const f32x4 (&acc0)[2][2][4][2], const Unit& u, int wr, int wc, int fr, int fq) const {
        unsigned char* ws = WSP(); float* out = OUTP(); const int layer = st / 3; const float* qg = INP(21) + layer * 64; const float* kg = INP(22) + layer * 64;
        const int row0 = u.pm * RM + wr * 64 + fr, pn = u.pn;
        bf16* UP = (bf16*)(ws + WS_UP); bf16* GLU = (bf16*)(ws + WS_GLU); bf16* Q = (bf16*)(ws + WS_Q); bf16* Kb = (bf16*)(ws + WS_K); bf16* Vb = (bf16*)(ws + WS_V);
        float* outK = out + (size_t)T * DM; float* outV = outK + (size_t)32 * 2 * 256 * 128; const float* rope = (const float*)(ws + WS_ROPE);
        f32x4 acc[2][2][4][2];
        {   const LAS float* slot = (const LAS float*)(lds + PSLOT + (wr * 4 + wc) * 768);
            f32x4 bv[2][2];
#pragma unroll
            for (int bj = 0; bj < 2; ++bj)
#pragma unroll
                for (int n = 0; n < 2; ++n) bv[bj][n] = *(const LAS f32x4*)(slot + 128 + fq * 16 + bj * 8 + n * 4);
#pragma unroll
            for (int ai = 0; ai < (HALF ? 1 : 2); ++ai)
#pragma unroll
                for (int m = 0; m < 4; ++m) { const float rs = rsqrtf(slot[ai * 64 + m * 16 + fr] * (1.f / DM) + EPS);
#pragma unroll
                    for (int bj = 0; bj < 2; ++bj)
#pragma unroll
                        for (int n = 0; n < 2; ++n) acc[ai][bj][m][n] = acc0[ai][bj][m][n] * rs + bv[bj][n]; } }
        if (pn == 0) {
#pragma unroll
            for (int ai = 0; ai < (HALF ? 1 : 2); ++ai)
#pragma unroll
                for (int m = 0; m < 4; ++m) { bf16* rp = UP + (size_t)(row0 + ai * 128 + m * 16) * 256 + wc * 32 + 4 * fq;
#pragma unroll
                    for (int bj = 0; bj < 2; ++bj)
#pragma unroll
                        for (int n = 0; n < 2; ++n) { const f32x4 a = acc[ai][bj][m][n]; u32x2 w; w.x = pk2(a[0], a[1]); w.y = pk2(a[2], a[3]); *(u32x2*)(rp + bj * 128 + n * 16) = w; } }
        } else if (pn <= 2) {
#pragma unroll
            for (int ai = 0; ai < (HALF ? 1 : 2); ++ai)
#pragma unroll
                for (int m = 0; m < 4; ++m) { bf16* rp = GLU + (size_t)(row0 + ai * 128 + m * 16) * 256 + (pn - 1) * 128 + wc * 32 + 4 * fq;
#pragma unroll
                    for (int n = 0; n < 2; ++n) { const f32x4 a = acc[ai][0][m][n], b = acc[ai][1][m][n]; float v[4];
#pragma unroll
                        for (int j = 0; j < 4; ++j) v[j] = a[j] * fast_sigmoid(b[j]);
                        u32x2 w; w.x = pk2(v[0], v[1]); w.y = pk2(v[2], v[3]); *(u32x2*)(rp + n * 16) = w; } }
        } else {
            const bool latent = u.pm >= TC / RM;
            if (pn == 5 && wc >= 2) {
                const int kvh = wc - 2;
#pragma unroll
                for (int ai = 0; ai < (HALF ? 1 : 2); ++ai)
#pragma unroll
                    for (int m = 0; m < 4; ++m) { const int r = row0 + ai * 128 + m * 16;
                        bf16* rp = Vb + (size_t)r * 128 + kvh * 64 + 4 * fq;
                        float* op = outV + ((size_t)((r >> 8) * 2 + layer) * 256 + (r & 255)) * 128 + kvh * 64 + 4 * fq;
#pragma unroll
                        for (int bj = 0; bj < 2; ++bj)
#pragma unroll
                            for (int n = 0; n < 2; ++n) { const f32x4 a = acc[ai][bj][m][n]; u32x2 w; w.x = pk2(a[0], a[1]); w.y = pk2(a[2], a[3]); *(u32x2*)(rp + bj * 32 + n * 16) = w;
                                if (!latent) *(f32x4*)(op + bj * 32 + n * 16) = a; } }
            } else {
                const bool isK = (pn == 5);
                const float* gam = isK ? kg : qg;
                const float qscale = isK ? 1.f : 0.125f * LOG2E;
                f32x4 gv[2][2];
#pragma unroll
                for (int bj = 0; bj < 2; ++bj)
#pragma unroll
                    for (int n = 0; n < 2; ++n) gv[bj][n] = *(const f32x4*)(gam + 32 * bj + 16 * n + 4 * fq);
#pragma unroll
                for (int ai = 0; ai < (HALF ? 1 : 2); ++ai)
#pragma unroll
                    for (int m = 0; m < 4; ++m) { const int r = row0 + ai * 128 + m * 16;
                        float ss = 0.f;
#pragma unroll
                        for (int bj = 0; bj < 2; ++bj)
#pragma unroll
                            for (int n = 0; n < 2; ++n) { const f32x4 a = acc[ai][bj][m][n]; ss += (a[0] * a[0] + a[1] * a[1]) + (a[2] * a[2] + a[3] * a[3]); }
                        ss += __shfl_xor(ss, 16); ss += __shfl_xor(ss, 32);
                        const float rstd = rsqrtf(ss * (1.f / 64.f) + EPS);
                        f32x4 val[2][2];
#pragma unroll
                        for (int bj = 0; bj < 2; ++bj)
#pragma unroll
                            for (int n = 0; n < 2; ++n) val[bj][n] = acc[ai][bj][m][n] * rstd * gv[bj][n];
                        if (isK && !latent) { float* op = outK + ((size_t)((r >> 8) * 2 + layer) * 256 + (r & 255)) * 128 + wc * 64 + 4 * fq;
#pragma unroll
                            for (int bj = 0; bj < 2; ++bj)
#pragma unroll
                                for (int n = 0; n < 2; ++n) *(f32x4*)(op + bj * 32 + n * 16) = val[bj][n]; }
                        if (latent) { const int t = (r - TC) & 4095;
#pragma unroll
                            for (int bj = 0; bj < 2; ++bj) { const int pos = bj ? (t & 63) : (t >> 6);
                                const f32x4 cs0 = *(const f32x4*)(rope + (pos * 16 + 4 * fq) * 2), cs1 = *(const f32x4*)(rope + (pos * 16 + 4 * fq) * 2 + 4);
                                const float cj[4] = {cs0[0], cs0[2], cs1[0], cs1[2]}, sj[4] = {cs0[1], cs0[3], cs1[1], cs1[3]};
#pragma unroll
                                for (int j = 0; j < 4; ++j) { const float x1 = val[bj][0][j], x2 = val[bj][1][j]; val[bj][0][j] = x1 * cj[j] - x2 * sj[j]; val[bj][1][j] = x2 * cj[j] + x1 * sj[j]; } } }
                        bf16* rp = isK ? (Kb + (size_t)r * 128 + wc * 64 + 4 * fq) : (Q + (size_t)r * 512 + ((pn - 3) * 4 + wc) * 64 + 4 * fq);
#pragma unroll
                        for (int bj = 0; bj < 2; ++bj)
#pragma unroll
                            for (int n = 0; n < 2; ++n) { const f32x4 a = val[bj][n] * qscale; u32x2 w; w.x = pk2(a[0], a[1]); w.y = pk2(a[2], a[3]); *(u32x2*)(rp + bj * 32 + n * 16) = w; } }
            }
        }
    }
};

typedef EpiInProjT<false> EpiInProj;
struct TailListOrder {
    int c, kind;
    __device__ __forceinline__ bool next(int i, Unit& u) const {
        if (i != 0 || c >= 128) return false;
        if (kind == 0) { u.pm = 184 + (c & 7); u.pn = 6 + (c >> 3); }
        else if (c < 32) { u.pm = 160 + (c & 15); u.pn = 4 + (c >> 4); }
        else { u.pm = 176 + ((c - 32) & 15); u.pn = (c - 32) >> 4; }
        return true; }
    __device__ __forceinline__ void a_ready(const Unit&) const {}
    __device__ __forceinline__ void done(const Unit&) const {}
};
__device__ __forceinline__ int map_row(int kind, int n) {
    if (kind == 1) { const int half = n >= DFF ? 1 : 0, j = n - half * DFF; return (j >> 7) * 256 + half * 128 + (j & 127); }
    if (kind == 2) {
        if (n < 256) return n;
        if (n < 768) { const int b = n >= 512 ? 1 : 0, ch = n - 256 - b * 256; return 256 * (1 + (ch >> 7)) + b * 128 + (ch & 127); }
        if (n < 1280) { const int h = (n - 768) >> 6, d = n & 63; return 256 * (3 + (h >> 2)) + 128 * (d >> 5) + 32 * (h & 3) + (d & 31); }
        { const int hh = (n - 1280) >> 6, d = n & 63; return 1280 + 128 * (d >> 5) + 32 * hh + (d & 31); }
    }
    return n;
}
__device__ __forceinline__ void p0_transpose_item(const float* W, int N, bf16* WT, int Kd, int koff, int kind, LAS float* scr, int item, int lane) {
    const int nblk = N / 32, kb = item / nblk, nb = item % nblk, k0 = 64 * kb, n0 = 32 * nb;
#pragma unroll
    for (int i = 0; i < 32; ++i) { const int kk = 2 * i + (lane >> 5); scr[kk * 33 + (lane & 31)] = __builtin_nontemporal_load(W + (size_t)(k0 + kk) * N + n0 + (lane & 31)); }
    LDS_WAIT(); asm volatile("" ::: "memory");
    const int c = lane & 7;
#pragma unroll
    for (int j = 0; j < 4; ++j) { const int n = (lane >> 3) + 8 * j; const LAS float* s = scr + (8 * c) * 33 + n;
        u32x4 o; o.x = pk2(s[0 * 33], s[1 * 33]); o.y = pk2(s[2 * 33], s[3 * 33]); o.z = pk2(s[4 * 33], s[5 * 33]); o.w = pk2(s[6 * 33], s[7 * 33]);
        *(u32x4*)(WT + (size_t)map_row(kind, n0 + n) * Kd + koff + k0 + 8 * c) = o; }
    LDS_WAIT(); asm volatile("" ::: "memory");
}

__device__ __forceinline__ void p0_prologue(LAS unsigned char* lds, int tid, int lane, int wave) {
    unsigned char* ws = WSP();
    const int G = gridDim.x, bx = blockIdx.x, gw = bx * 8 + wave, NGW = G * 8, gt = bx * NTHREADS + tid, NGT = G * NTHREADS;
    {
        LAS float* sil = (LAS float*)lds;
        { const float* cc = INP(5); const float* cl = INP(4);
        for (int i = tid; i < 5 * 1024; i += NTHREADS) { const int c = i >> 10, k = i & 1023; const float v = (c == 0) ? cc[k] : cl[(c - 1) * 1024 + k]; sil[i] = v * fast_sigmoid(v); } }
        __syncthreads();
        float* mods = (float*)(ws + WS_MODS); const float* modw = INP(6); const float* modb = INP(7);
        for (int it = gw; it < 9216; it += NGW) {
            const int l = it / 4608, rem = it % 4608, jb = rem >> 5, kc = rem & 31;
            const float* wp = modw + ((size_t)l * 1024 + kc * 32) * NMODV + jb * 64 + lane;
            float wv[32];
#pragma unroll
            for (int k = 0; k < 32; ++k) wv[k] = __builtin_nontemporal_load(wp + (size_t)k * NMODV);
            float a0 = 0.f, a1 = 0.f, a2 = 0.f, a3 = 0.f, a4 = 0.f;
#pragma unroll
            for (int k = 0; k < 32; ++k) { const float w = wv[k]; const int kk = kc * 32 + k; if ((k & 7) == 0) __builtin_amdgcn_sched_barrier(0);
                a0 += sil[kk] * w; a1 += sil[1024 + kk] * w; a2 += sil[2048 + kk] * w; a3 += sil[3072 + kk] * w; a4 += sil[4096 + kk] * w; }
            if (kc == 0) { const float bb = modb[l * NMODV + jb * 64 + lane]; a0 += bb; a1 += bb; a2 += bb; a3 += bb; a4 += bb; }
            float* mp = mods + (size_t)(l * 5) * NMODV + jb * 64 + lane;
            unsafeAtomicAdd(mp, a0); unsafeAtomicAdd(mp + NMODV, a1); unsafeAtomicAdd(mp + 2 * NMODV, a2); unsafeAtomicAdd(mp + 3 * NMODV, a3); unsafeAtomicAdd(mp + 4 * NMODV, a4);
        }
    }
    if (gt < 1024) { const int pos = gt >> 4, i = gt & 15; const float inv = exp2f(-(float)i * (13.287712379549449f / 16.f)); float s, c; sincosf((float)pos * inv, &s, &c);
        float* rope = (float*)(ws + WS_ROPE); rope[gt * 2] = c; rope[gt * 2 + 1] = s; }
    __syncthreads();
    { const f32x4* ck = (const f32x4*)INP(2); const f32x4* cv = (const f32x4*)INP(3); u32x2* ok = (u32x2*)(ws + WS_CK); u32x2* ov = (u32x2*)(ws + WS_CV);
        for (int i = gt; i < 4 * 2 * 512 * 128 / 4; i += NGT) { const f32x4 a = ck[i], b = cv[i]; u32x2 w; w.x = pk2(a[0], a[1]); w.y = pk2(a[2], a[3]); ok[i] = w; w.x = pk2(b[0], b[1]); w.y = pk2(b[2], b[3]); ov[i] = w; } }
    {
        LAS float* scr = (LAS float*)(lds + wave * 16384);
        constexpr int I_WI = 16 * 176, I_WO = 44 * 32, I_IN = 16 * 48, I_OUT = 8 * 32, I_L = 2 * I_WI + 2 * I_WO + I_IN + I_OUT;
        for (int it = gw; it < 2 * I_L; it += NGW) {
            const int l = it / I_L; int r = it % I_L; bf16* wb = (bf16*)(ws + WS_W + (size_t)l * W_LAYER);
            if (r < I_WI) { p0_transpose_item(INP(9) + (size_t)l * DM * 2 * DFF, 2 * DFF, (bf16*)((unsigned char*)wb + W_WI1), DM, 0, 1, scr, r, lane); continue; } r -= I_WI;
            if (r < I_WI) { p0_transpose_item(INP(11) + (size_t)l * DM * 2 * DFF, 2 * DFF, (bf16*)((unsigned char*)wb + W_WI2), DM, 0, 1, scr, r, lane); continue; } r -= I_WI;
            if (r < I_WO) { p0_transpose_item(INP(10) + (size_t)l * DFF * DM, DM, (bf16*)((unsigned char*)wb + W_WO1), DFF, 0, 0, scr, r, lane); continue; } r -= I_WO;
            if (r < I_WO) { p0_transpose_item(INP(12) + (size_t)l * DFF * DM, DM, (bf16*)((unsigned char*)wb + W_WO2), DFF, 0, 0, scr, r, lane); continue; } r -= I_WO;
            if (r < I_IN) { p0_transpose_item(INP(13) + (size_t)l * DM * NIN, NIN, (bf16*)((unsigned char*)wb + W_WIN), DM, 0, 2, scr, r, lane); continue; } r -= I_IN;
            p0_transpose_item(INP(14) + (size_t)l * DM * DM + (size_t)512 * DM, DM, (bf16*)((unsigned char*)wb + W_WOUT), DM, 512, 0, scr, r, lane);
        }
    }
    {
        LAS float* pws = (LAS float*)(lds + wave * 16384);
        for (int it = gw; it < 1024; it += NGW) {
            const int l = it >> 9, rb = (it >> 4) & 31, nb = it & 15, r0 = 16 * rb, n = nb * 64 + lane;
            const float* wo = INP(14) + (size_t)l * DM * DM;
            const bool pool = r0 < 256; const int KC = pool ? 64 : 256;
            const float* wrow;
            if (pool) { const int j = r0 >> 6; const float* pw = INP(15) + (size_t)(l * 4 + j) * 4096 + (r0 & 63) * 64; const float ps = INP(16)[l * 256 + 64 * j + lane]; wrow = wo + (size_t)(64 * j) * DM + n;
#pragma unroll
                for (int i = 0; i < 16; ++i) pws[i * 256 + lane] = pw[i * 64 + lane] * ps; }
            else { const float* pw = INP(20) + (size_t)l * 65536 + (size_t)(r0 - 256) * 256; wrow = wo + (size_t)256 * DM + n;
#pragma unroll
                for (int i = 0; i < 16; ++i) *(LAS f32x4*)(pws + i * 256 + lane * 4) = *(const f32x4*)(pw + i * 256 + lane * 4); }
            LDS_WAIT(); asm volatile("" ::: "memory");
            float a[16];
#pragma unroll
            for (int i = 0; i < 16; ++i) a[i] = 0.f;
#pragma unroll 1
            for (int c0 = 0; c0 < KC; c0 += 16) {
                float w[16];
#pragma unroll
                for (int q = 0; q < 16; ++q) w[q] = wrow[(size_t)(c0 + q) * DM];
#pragma unroll
                for (int q4 = 0; q4 < 4; ++q4) {
#pragma unroll
                    for (int i = 0; i < 16; ++i) { const f32x4 pv = *(const LAS f32x4*)(pws + i * 256 + c0 + 4 * q4); a[i] += pv[0] * w[4 * q4] + pv[1] * w[4 * q4 + 1] + pv[2] * w[4 * q4 + 2] + pv[3] * w[4 * q4 + 3]; }
                }
            }
            bf16* wt = (bf16*)(ws + WS_W + (size_t)l * W_LAYER + W_WOUT) + (size_t)n * DM + r0;
            u32x4 w0, w1; w0.x = pk2(a[0], a[1]); w0.y = pk2(a[2], a[3]); w0.z = pk2(a[4], a[5]); w0.w = pk2(a[6], a[7]); w1.x = pk2(a[8], a[9]); w1.y = pk2(a[10], a[11]); w1.z = pk2(a[12], a[13]); w1.w = pk2(a[14], a[15]);
            *(u32x4*)wt = w0; *(u32x4*)(wt + 8) = w1;
            LDS_WAIT(); asm volatile("" ::: "memory");
        }
    }
}

__device__ __forceinline__ void n0_phase(LAS unsigned char* lds, int tid, int lane, int wave) {
    unsigned char* ws = WSP();
    const int G = gridDim.x, bx = blockIdx.x, gw = bx * 8 + wave, NGW = G * 8, gt = bx * NTHREADS + tid, NGT = G * NTHREADS;
    const float* mods = (const float*)(ws + WS_MODS);
    {   const float* ngp = INP(8); float* gs = (float*)(ws + WS_GS);
        for (int i = gt; i < 2 * 3 * 5 * 1024; i += NGT) { const int k = i & 1023, c = (i >> 10) % 5, lk = i / 5120, l = lk / 3, kind = lk % 3;
            const float gsv = ngp[(size_t)(l * 3 + kind) * DM + k] * (1.f + mods[(size_t)(l * 5 + c) * NMODV + (3 * kind + 1) * 1024 + k]);
            gs[i] = gsv; ((float*)(ws + WS_IGS))[i] = (fabsf(gsv) > 1e-30f) ? 1.f / gsv : 0.f; } }
    {   const float* ngp = INP(8); const float* xa = INP(0); const float* xb = INP(1) - (size_t)TC * DM; bf16* H = (bf16*)(ws + WS_H); float* rsq = (float*)(ws + WS_RSQ);
        for (int r0 = gw; r0 < T; r0 += 2 * NGW) {
            const int r1 = r0 + NGW; const bool has1 = r1 < T;
            const float* xr0 = (r0 < TC ? xa : xb) + (size_t)r0 * DM; const float* xr1 = has1 ? (r1 < TC ? xa : xb) + (size_t)r1 * DM : xr0;
            f32x4 v0[4], v1[4];
#pragma unroll
            for (int j = 0; j < 4; ++j) v0[j] = __builtin_nontemporal_load((const f32x4*)xr0 + lane + 64 * j);
#pragma unroll
            for (int j = 0; j < 4; ++j) v1[j] = __builtin_nontemporal_load((const f32x4*)xr1 + lane + 64 * j);
#pragma unroll
            for (int h = 0; h < 2; ++h) { if (h == 1 && !has1) break;
                const int r = h ? r1 : r0; const f32x4* v = h ? v1 : v0;
                const float* mp = mods + cond_of(r) * NMODV + 1024;
                float s = 0.f;
#pragma unroll
                for (int j = 0; j < 4; ++j) s += (v[j][0] * v[j][0] + v[j][1] * v[j][1]) + (v[j][2] * v[j][2] + v[j][3] * v[j][3]);
                s = wave_sum(s);
                if (lane == 0) rsq[r] = s;
#pragma unroll
                for (int j = 0; j < 4; ++j) { const int c = 4 * (lane + 64 * j);
                    const f32x4 g = *(const f32x4*)(ngp + c), sc = *(const f32x4*)(mp + c);
                    const f32x4 y = v[j] * g * (sc + 1.f);
                    u32x2 w; w.x = pk2(y[0], y[1]); w.y = pk2(y[2], y[3]); *(u32x2*)(H + (size_t)r * DM + c) = w; } }
        }
    }
#pragma unroll 1
    for (int combo = 0; combo < 6; ++combo) {
        const int l = combo / 3, kind = combo % 3, N = (kind == 1) ? NIN : 2 * DFF;
        const bf16* Bt = (const bf16*)(ws + WS_W + (size_t)l * W_LAYER + (kind == 0 ? W_WI1 : (kind == 1 ? W_WIN : W_WI2)));
        float* bo = (float*)(ws + WS_BIAS) + l * BIAS_L + bias_off(kind);
        float sh[5][16];
#pragma unroll
        for (int c = 0; c < 5; ++c)
#pragma unroll
            for (int q = 0; q < 4; ++q) { const f32x4 t = *(const f32x4*)(mods + (size_t)(l * 5 + c) * NMODV + (3 * kind) * 1024 + lane * 16 + 4 * q); sh[c][4 * q] = t[0]; sh[c][4 * q + 1] = t[1]; sh[c][4 * q + 2] = t[2]; sh[c][4 * q + 3] = t[3]; }
        for (int n = gw; n < N; n += NGW) {
            const u32x4 w0 = *(const u32x4*)(Bt + (size_t)n * DM + lane * 16), w1 = *(const u32x4*)(Bt + (size_t)n * DM + lane * 16 + 8);
            const unsigned wv[8] = {w0.x, w0.y, w0.z, w0.w, w1.x, w1.y, w1.z, w1.w};
            float d[5] = {0.f, 0.f, 0.f, 0.f, 0.f};
#pragma unroll
            for (int e = 0; e < 8; ++e) { const float lo = __builtin_bit_cast(float, wv[e] << 16), hi = __builtin_bit_cast(float, wv[e] & 0xffff0000u);
#pragma unroll
                for (int c = 0; c < 5; ++c) d[c] += sh[c][2 * e] * lo + sh[c][2 * e + 1] * hi; }
#pragma unroll
            for (int c = 0; c < 5; ++c) { const float t = wave_sum(d[c]); if (lane == 0) bo[c * N + n] = t; }
        }
    }
}

__device__ __forceinline__ void poolconv_units(int pc0, int npc, unsigned char* ws, const float* dwl, const float* dbl, const float* cngl, LAS unsigned char* lds, int tid, int lane, int wave) {
    constexpr int GS = 0, US = 31744, YS = 56320;
    const bf16* UP = (const bf16*)(ws + WS_UP); const bf16* GLU = (const bf16*)(ws + WS_GLU); bf16* MIX = (bf16*)(ws + WS_MIX);
    const int c = tid & 255, half = tid >> 8;
    const int srow = tid >> 5, sch = tid & 31;
    u32x4 sg[4], su[3];
#define PC_BOUNDS(PC) const int m0 = (PC) * 32; int s_lo, s_hi; if (m0 < TC) { s_lo = m0 & ~255; s_hi = s_lo + 256; } else { s_lo = TC + ((m0 - TC) & ~4095); s_hi = s_lo + 4096; }
#define PC_LOAD(PC) do { PC_BOUNDS(PC) \
        _Pragma("unroll") for (int i = 0; i < 4; ++i) { const int row = srow + 16 * i, gr = m0 - 15 + row; sg[i] = (u32x4){0u, 0u, 0u, 0u}; if (row < 62 && gr >= s_lo && gr < s_hi) sg[i] = *(const u32x4*)(GLU + (size_t)gr * 256 + sch * 8); } \
        _Pragma("unroll") for (int i = 0; i < 3; ++i) { const int row = srow + 16 * i, gr = m0 - 8 + row; su[i] = (u32x4){0u, 0u, 0u, 0u}; if (gr >= s_lo && gr < s_hi) su[i] = *(const u32x4*)(UP + (size_t)gr * 256 + sch * 8); } } while (0)
    PC_LOAD(pc0);
    const float bias = dbl[c];
    const f32x4 g4 = *(const f32x4*)(cngl + lane * 4);
#pragma unroll 1
    for (int k = 0; k < npc; ++k) {
        PC_BOUNDS(pc0 + k)
        LDS_BARRIER();
#pragma unroll
        for (int i = 0; i < 4; ++i) { const int row = srow + 16 * i; if (row < 62) *(LAS u32x4*)(lds + GS + row * 512 + sch * 16) = sg[i]; }
#pragma unroll
        for (int i = 0; i < 3; ++i) { const int row = srow + 16 * i; *(LAS u32x4*)(lds + US + row * 512 + sch * 16) = su[i]; }
        LDS_BARRIER();
        if (k + 1 < npc) PC_LOAD(pc0 + k + 1);
        {
            float dw[31];
#pragma unroll
            for (int j = 0; j < 31; ++j) dw[j] = dwl[j * 256 + c];
            float y[16];
#pragma unroll
            for (int o = 0; o < 16; ++o) y[o] = bias;
#pragma unroll
            for (int i = 0; i < 46; ++i) { const float v = bf2f(*(const LAS bf16*)(lds + GS + (16 * half + i) * 512 + c * 2));
#pragma unroll
                for (int o = 0; o < 16; ++o) { const int j = i - o; if (j >= 0 && j <= 30) y[o] += v * dw[j]; } }
#pragma unroll
            for (int o = 0; o < 16; ++o) *(LAS float*)(lds + YS + ((16 * half + o) * 256 + c) * 4) = y[o];
        }
        {
            const int jg = c >> 6;
            float pv[33]; pv[0] = 0.f;
#pragma unroll
            for (int i = 0; i < 32; ++i) pv[i + 1] = pv[i] + bf2f(*(const LAS bf16*)(lds + US + (16 * half + i) * 512 + c * 2));
#define POOL_BODY(W2) _Pragma("unroll") for (int o = 0; o < 16; ++o) { const int gm = m0 + 16 * half + o; int lo = gm - (W2), hi = gm + (W2); lo = lo < s_lo ? s_lo : lo; hi = hi > s_hi ? s_hi : hi; \
                const float self = pv[o + 9] - pv[o + 8]; const float pooled = (pv[o + 8 + (W2)] - pv[o + 8 - (W2)]) * __builtin_amdgcn_rcpf((float)(hi - lo)) - self; \
                MIX[(size_t)gm * DM + c] = (bf16)(pk2(pooled, 0.f) & 0xffffu); }
            if (jg == 0) { POOL_BODY(1) } else if (jg == 1) { POOL_BODY(2) } else if (jg == 2) { POOL_BODY(4) } else { POOL_BODY(8) }
#undef POOL_BODY
        }
        LDS_BARRIER();
#pragma unroll
        for (int tk = 0; tk < 4; ++tk) { const int tl = wave * 4 + tk;
            const f32x4 v = *(const LAS f32x4*)(lds + YS + (tl * 256 + lane * 4) * 4);
            const float ss = wave_sum((v[0] * v[0] + v[1] * v[1]) + (v[2] * v[2] + v[3] * v[3]));
            const float rstd = rsqrtf(ss * (1.f / 256.f) + EPS);
            f32x4 z = v * rstd * g4;
#pragma unroll
            for (int j = 0; j < 4; ++j) z[j] = z[j] * fast_sigmoid(z[j]);
            u32x2 w; w.x = pk2(z[0], z[1]); w.y = pk2(z[2], z[3]); *(u32x2*)(MIX + (size_t)(m0 + tl) * DM + 256 + lane * 4) = w; }
    }
#undef PC_LOAD
#undef PC_BOUNDS
}

#define MFMA32(a, b, c) __builtin_amdgcn_mfma_f32_32x32x16_bf16((a), (b), (c), 0, 0, 0)
__device__ __forceinline__ float max3f(float a, float b, float c) { float r; asm("v_max3_f32 %0, %1, %2, %3" : "=v"(r) : "v"(a), "v"(b), "v"(c)); return r; }
__device__ __forceinline__ void attn_unit(int au, int layer, unsigned char* ws, const float* sink_l, LAS unsigned char* lds, int tid, int lane, int wave) {
    constexpr int KS = 0, VS = 9216;
    const bf16* Qb = (const bf16*)(ws + WS_Q); const bf16* Kb = (const bf16*)(ws + WS_K); const bf16* Vb = (const bf16*)(ws + WS_V); const bf16* CK = (const bf16*)(ws + WS_CK); const bf16* CV = (const bf16*)(ws + WS_CV); bf16* MIX = (bf16*)(ws + WS_MIX);
    int rb, q0, kvh, nwin, wk0, nctx, cb; bool latent;
    if (au < 256) { latent = true; const int b = au >> 6, rem = au & 63; kvh = rem >> 5; const int qblk = rem & 31; rb = TC + b * 4096; q0 = qblk * 128;
        int lo = q0 - 128; if (lo < 0) lo = 0; int hi = q0 + 256; if (hi > 4096) hi = 4096; wk0 = lo; nwin = (hi - lo) >> 6; nctx = 8; cb = (b * 2 + layer) * 512; }
    else { latent = false; const int cu = au - 256, b = cu >> 2; kvh = (cu >> 1) & 1; const int qblk = cu & 1; rb = b * 256; q0 = qblk * 128; wk0 = 0; nwin = 4; nctx = 0; cb = 0; }
    const int nt = nwin + nctx;
    const int g = wave >> 1, rhalf = wave & 1, h = kvh * 4 + g, l31 = lane & 31, hf = lane >> 5;
    bf16x8 qf[2][4];
#pragma unroll
    for (int qb = 0; qb < 2; ++qb)
#pragma unroll
        for (int kk = 0; kk < 4; ++kk) qf[qb][kk] = *(const bf16x8*)(Qb + (size_t)(rb + q0 + 64 * rhalf + 32 * qb + l31) * 512 + h * 64 + 16 * kk + 8 * hf);
    const float sk = sink_l[h] * LOG2E;
    float mrow[2] = {sk, sk}, ls[2] = {0.f, 0.f};
    f32x16 O[2][2];
#pragma unroll
    for (int a = 0; a < 2; ++a)
#pragma unroll
        for (int b = 0; b < 2; ++b)
#pragma unroll
            for (int i = 0; i < 16; ++i) O[a][b][i] = 0.f;
    const int skey = tid >> 3, sdc = tid & 7;
#define ATT_LOAD(TI, KR, VR) do { const int t_ = (TI); if (t_ < nt) { \
        const bf16* kp_ = (t_ < nwin) ? Kb + (size_t)(rb + wk0 + 64 * t_ + skey) * 128 + kvh * 64 + sdc * 8 : CK + (size_t)(cb + 64 * (t_ - nwin) + skey) * 128 + kvh * 64 + sdc * 8; \
        const bf16* vp_ = (t_ < nwin) ? Vb + (size_t)(rb + wk0 + 64 * t_ + skey) * 128 + kvh * 64 + sdc * 8 : CV + (size_t)(cb + 64 * (t_ - nwin) + skey) * 128 + kvh * 64 + sdc * 8; \
        KR = *(const u32x4*)kp_; VR = *(const u32x4*)vp_; } } while (0)
    u32x4 kreg = {0u, 0u, 0u, 0u}, vreg = kreg, kr1 = kreg, vr1 = kreg, kr2 = kreg, vr2 = kreg;
    ATT_LOAD(0, kreg, vreg); ATT_LOAD(1, kr1, vr1); ATT_LOAD(2, kr2, vr2);
    for (int ti = 0; ti < nt; ++ti) {
        LDS_BARRIER();
        *(LAS u32x4*)(lds + KS + skey * 144 + sdc * 16) = kreg;
        {   const unsigned vv[4] = {vreg.x, vreg.y, vreg.z, vreg.w};
#pragma unroll
            for (int j = 0; j < 8; ++j) *(LAS bf16*)(lds + VS + (sdc * 8 + j) * 136 + skey * 2) = (bf16)((vv[j >> 1] >> ((j & 1) * 16)) & 0xffffu); }
        LDS_BARRIER();
        const bool win = ti < nwin;
        const int k0 = wk0 + 64 * ti;
        kreg = kr1; vreg = vr1; kr1 = kr2; vr1 = vr2;
        ATT_LOAD(ti + 3, kr2, vr2);
        const int rel = k0 - (q0 + 64 * rhalf);
        const bool domask = latent && win && (rel > 64 || rel < -64);
        if (latent && win && (rel > 128 || rel < -128)) continue;
#define ATT_QK(S0, S1, QB) do { const float nm_ = -mrow[QB];     \
            const f32x16 Z_ = {nm_, nm_, nm_, nm_, nm_, nm_, nm_, nm_, nm_, nm_, nm_, nm_, nm_, nm_, nm_, nm_}; \
            { const bf16x8 a0 = *(const LAS bf16x8*)(lds + KS + l31 * 144 + (8 * hf) * 2); const bf16x8 a1 = *(const LAS bf16x8*)(lds + KS + (32 + l31) * 144 + (8 * hf) * 2); \
              S0 = MFMA32(a0, qf[QB][0], Z_); S1 = MFMA32(a1, qf[QB][0], Z_); } \
            _Pragma("unroll") for (int kk = 1; kk < 4; ++kk) { \
                const bf16x8 a0 = *(const LAS bf16x8*)(lds + KS + l31 * 144 + (16 * kk + 8 * hf) * 2); const bf16x8 a1 = *(const LAS bf16x8*)(lds + KS + (32 + l31) * 144 + (16 * kk + 8 * hf) * 2); \
                S0 = MFMA32(a0, qf[QB][kk], S0); S1 = MFMA32(a1, qf[QB][kk], S1); } } while (0)
#define ATT_SM(S0, S1, QB) do { \
            if (domask) { const int qpos = q0 + 64 * rhalf + 32 * (QB) + l31; \
                _Pragma("unroll") for (int i = 0; i < 16; ++i) { const int d0 = qpos - (k0 + 8 * (i >> 2) + 4 * hf + (i & 3)); const int d1 = d0 - 32; \
                    if (d0 > 128 || d0 < -128) S0[i] = -1e30f; if (d1 > 128 || d1 < -128) S1[i] = -1e30f; } } \
            float mx = max3f(0.f, S0[0], S1[0]); \
            _Pragma("unroll") for (int i = 1; i < 16; ++i) mx = max3f(mx, S0[i], S1[i]); \
            const float dl = max3f(mx, mx, __shfl_xor(mx, 32));     \
            if (__builtin_amdgcn_ballot_w64(dl > 8.f) != 0ull) {     \
                const float alpha = __builtin_amdgcn_exp2f(-dl); mrow[QB] += dl; ls[QB] *= alpha; \
                S0 = S0 - dl; S1 = S1 - dl; \
                _Pragma("unroll") for (int i = 0; i < 16; ++i) { O[0][QB][i] *= alpha; O[1][QB][i] *= alpha; } } \
            _Pragma("unroll") for (int i = 0; i < 16; ++i) { S0[i] = __builtin_amdgcn_exp2f(S0[i]); S1[i] = __builtin_amdgcn_exp2f(S1[i]); } \
            {   const f32x16 t16 = S0 + S1; typedef float f32x8 __attribute__((ext_vector_type(8))); \
                const f32x8 t8 = __builtin_shufflevector(t16, t16, 0, 1, 2, 3, 4, 5, 6, 7) + __builtin_shufflevector(t16, t16, 8, 9, 10, 11, 12, 13, 14, 15); \
                const f32x4 t4 = __builtin_shufflevector(t8, t8, 0, 1, 2, 3) + __builtin_shufflevector(t8, t8, 4, 5, 6, 7); \
                ls[QB] += (t4[0] + t4[1]) + (t4[2] + t4[3]); } } while (0)
#define ATT_PV(S0, S1, QB) do { bf16x8 pf[2][2]; \
            _Pragma("unroll") for (int a = 0; a < 2; ++a) { \
                u32x4 w0; w0.x = pk2(S0[8 * a], S0[8 * a + 1]); w0.y = pk2(S0[8 * a + 2], S0[8 * a + 3]); w0.z = pk2(S0[8 * a + 4], S0[8 * a + 5]); w0.w = pk2(S0[8 * a + 6], S0[8 * a + 7]); \
                u32x4 w1; w1.x = pk2(S1[8 * a], S1[8 * a + 1]); w1.y = pk2(S1[8 * a + 2], S1[8 * a + 3]); w1.z = pk2(S1[8 * a + 4], S1[8 * a + 5]); w1.w = pk2(S1[8 * a + 6], S1[8 * a + 7]); \
                pf[0][a] = __builtin_bit_cast(bf16x8, w0); pf[1][a] = __builtin_bit_cast(bf16x8, w1); } \
            _Pragma("unroll") for (int db = 0; db < 2; ++db) _Pragma("unroll") for (int kb = 0; kb < 2; ++kb) _Pragma("unroll") for (int a = 0; a < 2; ++a) { const int Gk = 32 * kb + 16 * a; \
                const u32x2 lo8 = *(const LAS u32x2*)(lds + VS + (32 * db + l31) * 136 + (Gk + 4 * hf) * 2); const u32x2 hi8 = *(const LAS u32x2*)(lds + VS + (32 * db + l31) * 136 + (Gk + 8 + 4 * hf) * 2); \
                u32x4 av; av.x = lo8.x; av.y = lo8.y; av.z = hi8.x; av.w = hi8.y; \
                O[db][QB] = MFMA32(__builtin_bit_cast(bf16x8, av), pf[kb][a], O[db][QB]); } } while (0)
        {
            f32x16 Sa0, Sa1, Sb0, Sb1;
            __builtin_amdgcn_sched_barrier(0);
            ATT_QK(Sa0, Sa1, 0);
            ATT_QK(Sb0, Sb1, 1);
            __builtin_amdgcn_sched_barrier(0);
            ATT_SM(Sa0, Sa1, 0);
            __builtin_amdgcn_sched_barrier(0);
            ATT_PV(Sa0, Sa1, 0);
            __builtin_amdgcn_sched_barrier(0);
            ATT_SM(Sb0, Sb1, 1);
            __builtin_amdgcn_sched_barrier(0);
            ATT_PV(Sb0, Sb1, 1);
        }
#undef ATT_QK
#undef ATT_SM
#undef ATT_PV
#undef ATT_LOAD
    }
#pragma unroll
    for (int qb = 0; qb < 2; ++qb) {
        const float lt = ls[qb] + __shfl_xor(ls[qb], 32) + __builtin_amdgcn_exp2f(sk - mrow[qb]);
        const float inv = 1.f / lt;
        bf16* rp = MIX + (size_t)(rb + q0 + 64 * rhalf + 32 * qb + l31) * DM + 512 + h * 64 + 4 * hf;
#pragma unroll
        for (int db = 0; db < 2; ++db)
#pragma unroll
            for (int g4 = 0; g4 < 4; ++g4) { u32x2 w; w.x = pk2(O[db][qb][4 * g4] * inv, O[db][qb][4 * g4 + 1] * inv); w.y = pk2(O[db][qb][4 * g4 + 2] * inv, O[db][qb][4 * g4 + 3] * inv);
                *(u32x2*)(rp + 32 * db + 8 * g4) = w; }
    }
}

__global__ void __launch_bounds__(NTHREADS, 2) fwd_kernel(Params p) {
    extern __shared__ __attribute__((aligned(16))) unsigned char lds_raw[];
    cg::grid_group grid = cg::this_grid();
    LAS unsigned char* lds = (LAS unsigned char*)lds_raw;
#define PHASE_IDS() int tid = threadIdx.x; asm volatile("" : "+v"(tid)); const int lane = tid & 63, wave = __builtin_amdgcn_readfirstlane(tid >> 6); (void)lane; (void)wave
    { PHASE_IDS();
    if (tid < 26) { const unsigned long long __attribute__((address_space(4)))* ka = (const unsigned long long __attribute__((address_space(4)))*)__builtin_amdgcn_kernarg_segment_ptr();
        *(LAS unsigned long long*)(lds + PTAB + 8 * tid) = ka[tid]; }
    if (tid < 2) *(LAS unsigned*)(lds + PTAB + 256 + 4 * tid) = 0u;
    __syncthreads();
    (void)xcd_barrier_post((unsigned*)(WSP() + WS_CTL), (volatile LAS unsigned*)(lds + PTAB + 256));
    if (gridDim.x > 1000000u) grid.sync();
#ifndef NO_P0
    p0_prologue(lds, tid, lane, wave);
#endif
    }
    GRID_BAR();
    { PHASE_IDS(); n0_phase(lds, tid, lane, wave); }
    GRID_BAR();

#pragma unroll 1
    for (int st = 0; st < 6; ++st) {
        const int l = st / 3, kind = st % 3;
        if (kind == 1) {
            {   const int G = gridDim.x, bx = blockIdx.x; unsigned char* ws = WSP();
                pg8::Gemm g{(const bf16*)(ws + WS_H), (const bf16*)(ws + WS_W + (size_t)l * W_LAYER + W_WIN), T, NIN, DM}; pg8::StaticOrder S; S.init(T, NIN, G, bx);
                EpiInProj E{lds, st};
                pg8::gemm_phase<EpiInProj, pg8::StaticOrder, true, true>(lds, g, S, E);
            }
            GRID_BAR();
#ifndef NO_ATTN
            {   PHASE_IDS(); const int G = gridDim.x, bx = blockIdx.x;
                if (G == 256) {
                    attn_unit((bx & 7) * 32 + (bx >> 3), l, WSP(), INP(23) + l * 8, lds, tid, lane, wave);
                    if (bx < 128) attn_unit(256 + (bx & 7) * 16 + (bx >> 3), l, WSP(), INP(23) + l * 8, lds, tid, lane, wave); }
                else for (int it = bx; it < 384; it += G) attn_unit(it, l, WSP(), INP(23) + l * 8, lds, tid, lane, wave); }
#endif
#ifndef NO_PC
            {   PHASE_IDS(); const int G = gridDim.x, bx = blockIdx.x;
                if (G == 256) { const int npc = bx < 128 ? 2 : 4, pc0 = bx < 128 ? 2 * bx : 256 + 4 * (bx - 128);
                    poolconv_units(pc0, npc, WSP(), INP(17) + (size_t)l * 31 * 256, INP(18) + l * 256, INP(19) + l * 256, lds, tid, lane, wave); }
                else for (int it = bx; it < 768; it += G) poolconv_units(it, 1, WSP(), INP(17) + (size_t)l * 31 * 256, INP(18) + l * 256, INP(19) + l * 256, lds, tid, lane, wave); }
#endif
        } else {
            const int G = gridDim.x, bx = blockIdx.x; unsigned char* ws = WSP();
            pg8::Gemm g{(const bf16*)(ws + WS_H), (const bf16*)(ws + WS_W + (size_t)l * W_LAYER + (kind == 0 ? W_WI1 : W_WI2)), T, 2 * DFF, DM}; pg8::StaticOrder S; S.init(T, 2 * DFF, G, bx); const bool split = (G == 256); if (split) { S.nwg = 2048; S.wgm = 4; }
            EpiSwiglu E{lds, st};
            pg8::gemm_phase<EpiSwiglu, pg8::StaticOrder, true, true>(lds, g, S, E);
            if (split) { TailListOrder S2{bx, 0}; EpiSwigluT<true> E2{lds, st}; pg8::gemm_phase<EpiSwigluT<true>, TailListOrder, true, true, true>(lds, g, S2, E2); }
        }
        GRID_BAR();
        {   const int G = gridDim.x, bx = blockIdx.x; unsigned char* ws = WSP();
            const bf16* A = (const bf16*)(ws + ((kind == 1) ? WS_MIX : WS_ACT)); const int K = (kind == 1) ? DM : DFF;
            const bf16* B = (const bf16*)(ws + WS_W + (size_t)l * W_LAYER + (kind == 0 ? W_WO1 : (kind == 1 ? W_WOUT : W_WO2)));
            pg8::Gemm g{A, B, T, DM, K, 0, 0}; pg8::StaticOrder S; S.init(T, DM, G, bx); const bool split = (G == 256); if (split) S.nwg = 256;
            EpiResid E{lds, st};
#ifndef NO_G2
            pg8::gemm_phase<EpiResid, pg8::StaticOrder, RESID_ALIGN, true, false>(lds, g, S, E);
            if (split) { TailHalfOrder S2{bx, G}; EpiResidT<true> E2{lds, st}; pg8::gemm_phase<EpiResidT<true>, TailHalfOrder, RESID_ALIGN, true, true>(lds, g, S2, E2); }
#endif
        }
        if (st != 5) GRID_BAR();
    }
}

extern "C" void kernel_launch(void* const* d_in, const int* in_sizes, int n_in, void* d_out, int out_size, void* d_ws, size_t ws_size, hipStream_t stream) {
    static int grid = 0;
    if (grid == 0) {
        if (n_in != 24 || ws_size < WS_END) { fprintf(stderr, "kernel_launch: unexpected n_in %d / ws_size %zu\n", n_in, ws_size); grid = -1; return; }
        int dev = 0, cus = 0, per_cu = 0;
        hipGetDevice(&dev); hipDeviceGetAttribute(&cus, hipDeviceAttributeMultiprocessorCount, dev);
        if (hipFuncSetAttribute((const void*)fwd_kernel, hipFuncAttributeMaxDynamicSharedMemorySize, LDS_BYTES) != hipSuccess) { fprintf(stderr, "kernel_launch: hipFuncSetAttribute failed\n"); grid = -1; return; }
        if (hipOccupancyMaxActiveBlocksPerMultiprocessor(&per_cu, (const void*)fwd_kernel, NTHREADS, LDS_BYTES) != hipSuccess || per_cu < 1) { fprintf(stderr, "kernel_launch: occupancy query says %d\n", per_cu); per_cu = 1; }
        (void)hipGetLastError();
        grid = cus * (per_cu > 1 ? 1 : per_cu);
        fprintf(stderr, "kernel_launch: grid %d (cus %d, per_cu %d)\n", grid, cus, per_cu);
    }
    if (grid < 0) return;
    Params p{};
    for (int i = 0; i < 24; ++i) p.in[i] = (const float*)d_in[i];
    p.out = (float*)d_out; p.ws = (unsigned char*)d_ws;
    if (hipMemsetAsync((char*)d_ws + WS_CTL, 0, CTL_BYTES, stream) != hipSuccess) { fprintf(stderr, "kernel_launch: memset failed\n"); return; }
    void* args[] = {&p};
    hipError_t e = hipLaunchCooperativeKernel((const void*)fwd_kernel, dim3(grid), dim3(NTHREADS), args, LDS_BYTES, stream);
    if (e != hipSuccess) fprintf(stderr, "cooperative launch failed: %s (grid %d)\n", hipGetErrorString(e), grid);
}
```

```cpp
#include <hip/hip_runtime.h>
#include <hip/hip_cooperative_groups.h>
#include <cstdio>
#include <cstdint>
namespace cg = cooperative_groups;
namespace pg8 {
#define PG8_LAS __attribute__((address_space(3)))
typedef unsigned short bf16_t;
typedef short bf16x8 __attribute__((ext_vector_type(8)));
typedef float f32x4 __attribute__((ext_vector_type(4)));
typedef unsigned u32x4 __attribute__((ext_vector_type(4)));
constexpr int BM = 256, BK = 64, HALF = 128, HTB = HALF * BK * 2  , STAGE_BYTES = 8 * HTB, NXCD = 8, WGM = 8;

__host__ __device__ __forceinline__ int lds_byte(int r, int c) { const int st = (r >> 4) * 2 + (c >> 5), rr = r & 15, cc = c & 31, ob = rr * 64 + cc * 2; return st * 1024 + (ob ^ (((ob >> 9) & 1) << 5)); }
__host__ __device__ __forceinline__ void stage_rc(int b, int& R, int& C) { const int st = b / 1024, sb = b % 1024, swz = sb ^ (((sb >> 9) & 1) << 5); R = (st >> 1) * 16 + swz / 64; C = (st & 1) * 32 + (swz % 64) / 2; }
__host__ __device__ __forceinline__ int perm32(int rho) { const int n = rho >> 4, i = rho & 15; return 8 * (i >> 2) + 4 * n + (i & 3); }

struct Unit { int pm, pn; };
struct Gemm { const bf16_t* A; const bf16_t* Bt; int M, N, K; int ablk, bblk; };

struct StaticOrder {
    int nM, nN, nwg, G, c, wgm;
    __host__ __device__ void init(int M, int N, int G_, int c_, int bm = BM) { nM = M / bm; nN = N / BM; nwg = nM * nN; G = G_; c = c_; wgm = WGM; }
    __host__ __device__ bool next(int i, Unit& u) const {
        const long L = (long)i * G + c; if (L >= nwg) return false;
        int wgid = (int)L; { const int q = nwg / NXCD, r = nwg % NXCD, xcd = wgid % NXCD, off = wgid / NXCD; wgid = (xcd < r ? xcd * (q + 1) : r * (q + 1) + (xcd - r) * q) + off; }
        const int nig = wgm * nN, gid = wgid / nig, fm = gid * wgm, gsz = (nM - fm) < wgm ? (nM - fm) : wgm;
        u.pm = fm + ((wgid % nig) % gsz); u.pn = (wgid % nig) / gsz; return true;
    }
    __device__ __forceinline__ void a_ready(const Unit&) const {}
    __device__ __forceinline__ void done(const Unit&) const {}
};

__device__ __forceinline__ unsigned cvt_pk_bf16(float lo, float hi) { unsigned r; asm volatile("v_cvt_pk_bf16_f32 %0, %1, %2" : "=v"(r) : "v"(lo), "v"(hi)); return r; }
template <class Epi, class Sched, bool ALIGN_EPI = false, bool SP2 = false, bool HALFM = false>
__device__ __forceinline__ void gemm_phase(PG8_LAS unsigned char* lds, const Gemm g, const Sched& S, const Epi& E) {
    int tid_ = threadIdx.x; asm volatile("" : "+v"(tid_));
    const int tid = tid_, wid = __builtin_amdgcn_readfirstlane(tid >> 6), lane = tid & 63, wr = wid >> 2, wc = wid & 3, fr = lane & 15, fq = lane >> 4;
    const int K = g.K, nt = K / BK;
    unsigned voffA[2], voffB[2];
#pragma unroll
    for (int i = 0; i < 2; ++i) { int R, C; stage_rc(tid * 16 + i * 8192, R, C); const int Rb = Epi::PERM ? ((R & ~31) + perm32(R & 31)) : R;
        voffA[i] = (unsigned)(R * (g.ablk ? BK : K) + C) * 2u; voffB[i] = (unsigned)(Rb * (g.bblk ? BK : K) + C) * 2u; }
    const size_t kstepA = g.ablk ? (size_t)BM * BK * 2 : (size_t)(BK * 2), kstepB = g.bblk ? (size_t)BM * BK * 2 : (size_t)(BK * 2);
    const size_t hstepA = HALFM ? (size_t)0 : (g.ablk ? (size_t)HALF * BK * 2 : (size_t)HALF * K * 2), hstepB = g.bblk ? (size_t)HALF * BK * 2 : (size_t)HALF * K * 2;
    const size_t tstepB = (size_t)BM * K * 2, tstepA = HALFM ? tstepB / 2 : tstepB;
    const unsigned ldsw = (unsigned)wid * 1024u;
    const int aoff = lds_byte(wr * 64 + fr, fq * 8), boff = lds_byte(wc * 32 + fr, fq * 8);
#define PG8_SA(b, h) (((b) * 2 + (h)) * HTB)
#define PG8_SB(b, h) ((4 + (b) * 2 + (h)) * HTB)
#define PG8_STAGE(bufoff, gbase, voff) do { _Pragma("unroll") for (int _i = 0; _i < 2; ++_i) \
        __builtin_amdgcn_global_load_lds((const unsigned*)((const char*)(gbase) + (voff)[_i]), (PG8_LAS unsigned*)(lds + (bufoff) + ldsw + _i * 8192), 16, 0, 0); } while (0)
#define PG8_LDA(dst, b, h) do { _Pragma("unroll") for (int m = 0; m < 4; ++m) _Pragma("unroll") for (int k = 0; k < 2; ++k) dst[m][k] = *(const PG8_LAS bf16x8*)(lds + PG8_SA(b, h) + aoff + m * 2048 + k * 1024); } while (0)
#define PG8_LDB(dst, b, h) do { _Pragma("unroll") for (int n = 0; n < 2; ++n) _Pragma("unroll") for (int k = 0; k < 2; ++k) dst[n][k] = *(const PG8_LAS bf16x8*)(lds + PG8_SB(b, h) + boff + n * 2048 + k * 1024); } while (0)
#define PG8_MMA(ai, bj, At, Bt) do { __builtin_amdgcn_s_setprio(1); _Pragma("unroll") for (int m = 0; m < 4; ++m) _Pragma("unroll") for (int n = 0; n < 2; ++n) _Pragma("unroll") for (int k = 0; k < 2; ++k) \
        acc[ai][bj][m][n] = __builtin_amdgcn_mfma_f32_16x16x32_bf16(Bt[n][k], At[m][k], acc[ai][bj][m][n], 0, 0, 0); __builtin_amdgcn_s_setprio(0); } while (0)
#define PG8_WAIT_V(n) asm volatile("s_waitcnt vmcnt(" #n ")" ::: "memory")
#define PG8_WAIT_L(n) asm volatile("s_waitcnt lgkmcnt(" #n ")" ::: "memory")
#define PG8_BAR __builtin_amdgcn_s_barrier()
#define PG8_SCHED __builtin_amdgcn_sched_barrier(0)
    Unit cur, nxt; int ui = 0;
    if (!S.next(0, cur)) return;
    f32x4 acc[2][2][4][2];
#pragma unroll
    for (int a = 0; a < 2; ++a)
#pragma unroll
        for (int b = 0; b < 2; ++b)
#pragma unroll
            for (int m = 0; m < 4; ++m)
#pragma unroll
                for (int n = 0; n < 2; ++n) acc[a][b][m][n] = (f32x4){0.f, 0.f, 0.f, 0.f};
    bf16x8 At[4][2], B0[2][2], B1[2][2];
    const char* cA = (const char*)g.A + (size_t)cur.pm * tstepA; const char* cB = (const char*)g.Bt + (size_t)cur.pn * tstepB;
    S.a_ready(cur);
    if constexpr (Epi::PREFETCH) E.issue(cur, wid, wr, wc, lane);
    if constexpr (SP2) {
        PG8_STAGE(PG8_SB(0, 0), cB, voffB); PG8_STAGE(PG8_SB(0, 1), cB + hstepB, voffB); PG8_STAGE(PG8_SA(0, 0), cA, voffA); PG8_STAGE(PG8_SA(0, 1), cA + hstepA, voffA);
        if (wr == 1) PG8_BAR;
        PG8_WAIT_V(2); PG8_BAR;
        PG8_STAGE(PG8_SB(1, 0), cB + kstepB, voffB); PG8_STAGE(PG8_SA(1, 0), cA + kstepA, voffA); PG8_STAGE(PG8_SB(1, 1), cB + hstepB + kstepB, voffB);
        PG8_WAIT_V(6); PG8_BAR;
    } else {
        PG8_STAGE(PG8_SB(0, 0), cB, voffB); PG8_STAGE(PG8_SA(0, 0), cA, voffA); PG8_STAGE(PG8_SB(0, 1), cB + hstepB, voffB); PG8_STAGE(PG8_SA(0, 1), cA + hstepA, voffA);
        if (wr == 1) PG8_BAR;
        PG8_WAIT_V(4); PG8_BAR;
        PG8_STAGE(PG8_SB(1, 0), cB + kstepB, voffB); PG8_STAGE(PG8_SA(1, 0), cA + kstepA, voffA); PG8_STAGE(PG8_SB(1, 1), cB + hstepB + kstepB, voffB);
        PG8_WAIT_V(6); PG8_BAR;
    }
    for (;;) {
        const bool has_next = S.next(ui + 1, nxt);
        const char* nA = has_next ? (const char*)g.A + (size_t)nxt.pm * tstepA : cA; const char* nB = has_next ? (const char*)g.Bt + (size_t)nxt.pn * tstepB : cB;
        for (int t = 0; t < nt; t += 2) {
            const bool last = (t == nt - 2);
            const char* a1 = cA + (size_t)(t + 1) * kstepA;
            const char* a2 = last ? nA : cA + (size_t)(t + 2) * kstepA; const char* b2 = last ? nB : cB + (size_t)(t + 2) * kstepB;
            const char* a3 = a2 + kstepA; const char* b3 = b2 + kstepB;
            if (last && has_next) S.a_ready(nxt);
            if constexpr (SP2) {
            PG8_LDB(B0, 0, 0); PG8_LDB(B1, 0, 1); PG8_SCHED; PG8_LDA(At, 0, 0); PG8_STAGE(PG8_SA(1, 1), a1 + hstepA, voffA);
            PG8_WAIT_V(8); PG8_WAIT_L(0); PG8_BAR; PG8_MMA(0, 0, At, B0); PG8_MMA(0, 1, At, B1); PG8_BAR; PG8_SCHED;
            if constexpr (!HALFM) { PG8_LDA(At, 0, 1); } PG8_STAGE(PG8_SB(0, 0), b2, voffB); PG8_STAGE(PG8_SB(0, 1), b2 + hstepB, voffB); PG8_STAGE(PG8_SA(0, 0), a2, voffA);
            PG8_WAIT_V(8); PG8_WAIT_L(0); PG8_BAR; if constexpr (!HALFM) { PG8_MMA(1, 0, At, B0); PG8_MMA(1, 1, At, B1); } PG8_BAR; PG8_SCHED;
            PG8_LDB(B0, 1, 0); PG8_LDB(B1, 1, 1); PG8_SCHED; PG8_LDA(At, 1, 0); PG8_STAGE(PG8_SA(0, 1), a2 + hstepA, voffA);
            PG8_WAIT_V(8); PG8_WAIT_L(0); PG8_BAR; PG8_MMA(0, 0, At, B0); PG8_MMA(0, 1, At, B1); PG8_BAR; PG8_SCHED;
            if constexpr (!HALFM) { PG8_LDA(At, 1, 1); } PG8_STAGE(PG8_SB(1, 0), b3, voffB); PG8_STAGE(PG8_SB(1, 1), b3 + hstepB, voffB); PG8_STAGE(PG8_SA(1, 0), a3, voffA);
            PG8_WAIT_V(8); PG8_WAIT_L(0); PG8_BAR; if constexpr (!HALFM) { PG8_MMA(1, 0, At, B0); PG8_MMA(1, 1, At, B1); } PG8_BAR; PG8_SCHED;
            } else {
            PG8_LDB(B0, 0, 0); PG8_SCHED; PG8_LDA(At, 0, 0); PG8_STAGE(PG8_SA(1, 1), a1 + hstepA, voffA);
            PG8_WAIT_L(8); PG8_BAR; PG8_WAIT_L(0); PG8_MMA(0, 0, At, B0); PG8_BAR; PG8_SCHED;
            PG8_LDB(B1, 0, 1); PG8_STAGE(PG8_SB(0, 0), b2, voffB);
            PG8_BAR; PG8_WAIT_L(0); PG8_MMA(0, 1, At, B1); PG8_BAR;
            PG8_LDA(At, 0, 1); PG8_STAGE(PG8_SA(0, 0), a2, voffA);
            PG8_BAR; PG8_WAIT_L(0); PG8_MMA(1, 0, At, B0); PG8_BAR; PG8_SCHED;
            PG8_STAGE(PG8_SB(0, 1), b2 + hstepB, voffB);
            PG8_WAIT_V(6); PG8_BAR; PG8_MMA(1, 1, At, B1); PG8_BAR;
            PG8_LDB(B0, 1, 0); PG8_SCHED; PG8_LDA(At, 1, 0); PG8_STAGE(PG8_SA(0, 1), a2 + hstepA, voffA);
            PG8_WAIT_L(8); PG8_BAR; PG8_WAIT_L(0); PG8_MMA(0, 0, At, B0); PG8_BAR; PG8_SCHED;
            PG8_LDB(B1, 1, 1); PG8_STAGE(PG8_SB(1, 0), b3, voffB);
            PG8_BAR; PG8_WAIT_L(0); PG8_MMA(0, 1, At, B1); PG8_BAR;
            PG8_LDA(At, 1, 1); PG8_STAGE(PG8_SA(1, 0), a3, voffA);
            PG8_BAR; PG8_WAIT_L(0); PG8_MMA(1, 0, At, B0); PG8_BAR; PG8_SCHED;
            PG8_STAGE(PG8_SB(1, 1), b3 + hstepB, voffB);
            PG8_WAIT_V(6); PG8_BAR; PG8_MMA(1, 1, At, B1); PG8_BAR;
            }
        }
        if constexpr (ALIGN_EPI) { if (wr == 0) PG8_BAR; }
        if constexpr (!Epi::AFTER_DRAIN) { E(acc, cur, wr, wc, fr, fq); S.done(cur); }
        if (!has_next) break;
#pragma unroll
        for (int a = 0; a < 2; ++a)
#pragma unroll
            for (int b = 0; b < 2; ++b)
#pragma unroll
                for (int m = 0; m < 4; ++m)
#pragma unroll
                    for (int n = 0; n < 2; ++n) acc[a][b][m][n] = (f32x4){0.f, 0.f, 0.f, 0.f};
        cur = nxt; cA = nA; cB = nB; ++ui;
        if constexpr (Epi::PREFETCH) E.issue(cur, wid, wr, wc, lane);
        if constexpr (ALIGN_EPI) { if (wr == 1) PG8_BAR; }
    }
    PG8_WAIT_V(0);
    if constexpr (!ALIGN_EPI) { if (wr == 0) PG8_BAR; }
    PG8_BAR;
    if constexpr (Epi::AFTER_DRAIN) { E.fused(acc, cur, wr, wc, fr, fq, lds, wid, lane); S.done(cur); }
#undef PG8_SA
#undef PG8_SB
#undef PG8_STAGE
#undef PG8_LDA
#undef PG8_LDB
#undef PG8_MMA
#undef PG8_WAIT_V
#undef PG8_WAIT_L
#undef PG8_BAR
#undef PG8_SCHED
}
}

#define LAS __attribute__((address_space(3)))
typedef unsigned short bf16;
typedef float f32x4 __attribute__((ext_vector_type(4)));
typedef float f32x16 __attribute__((ext_vector_type(16)));
typedef short bf16x8 __attribute__((ext_vector_type(8)));
typedef unsigned u32x4 __attribute__((ext_vector_type(4)));
typedef unsigned u32x2 __attribute__((ext_vector_type(2)));
typedef __bf16 bf16x2_t __attribute__((ext_vector_type(2)));
typedef float f32x2_t __attribute__((ext_vector_type(2)));
#define LDS_WAIT() asm volatile("s_waitcnt lgkmcnt(0)" ::: "memory")
#define LDS_BARRIER() do { asm volatile("s_waitcnt lgkmcnt(0)" ::: "memory"); __builtin_amdgcn_s_barrier(); asm volatile("" ::: "memory"); } while (0)

constexpr int DM = 1024, TC = 8192, TL = 16384, T = 24576, DFF = 2816, NIN = 1536, NMODV = 9216;
constexpr float EPS = 1e-6f, LOG2E = 1.4426950408889634f;
constexpr size_t MiB = 1u << 20;
constexpr size_t WS_ROPE = 512 * 1024, WS_CK = 1 * MiB, WS_CV = 2 * MiB, WS_W = 4 * MiB, W_LAYER = 38 * MiB;
constexpr size_t W_WI1 = 0, W_WO1 = 11 * MiB, W_WI2 = 16 * MiB + 512 * 1024, W_WO2 = 27 * MiB + 512 * 1024, W_WIN = 33 * MiB, W_WOUT = 36 * MiB;
constexpr size_t WS_H = 80 * MiB, WS_ACT = 128 * MiB, WS_UP = 128 * MiB, WS_GLU = 140 * MiB, WS_Q = 152 * MiB, WS_K = 176 * MiB, WS_V = 182 * MiB, WS_MIX = 188 * MiB, WS_BIAS = 260 * MiB, WS_GS = WS_BIAS + 512 * 1024, WS_IGS = WS_BIAS + 768 * 1024, WS_X16 = 261 * MiB, WS_END = 309 * MiB;
constexpr size_t WS_CTL = 3 * MiB, CTL_BYTES = 1 * MiB;
constexpr size_t WS_RSQ = WS_CTL + 64 * 1024, WS_MODS = WS_CTL + 640 * 1024;
constexpr int BIAS_L = 64000;
__host__ __device__ constexpr int bias_off(int kind) { return kind == 0 ? 0 : (kind == 1 ? 28160 : 35840); }
constexpr int LDS_BYTES = 131072 + 1024 + 8 * 768;
constexpr int PSLOT = 131072 + 1024;
constexpr int NTHREADS = 512;
#ifndef RESID_ALIGN
#define RESID_ALIGN true
#endif

__device__ __forceinline__ unsigned pk2(float lo, float hi) { f32x2_t v = {lo, hi}; return __builtin_bit_cast(unsigned, __builtin_convertvector(v, bf16x2_t)); }
__device__ __forceinline__ float bf2f(bf16 b) { return __builtin_bit_cast(float, (unsigned)b << 16); }
__device__ __forceinline__ float wave_sum(float v) {
#pragma unroll
    for (int o = 1; o < 64; o <<= 1) v += __shfl_xor(v, o);
    return v;
}
__device__ __forceinline__ float fast_sigmoid(float x) { return __builtin_amdgcn_rcpf(1.f + __builtin_amdgcn_exp2f(-x * LOG2E)); }
__device__ __forceinline__ int cond_of(int r) { return r < TC ? 0 : 1 + ((r - TC) >> 12); }

struct Params { const float* in[24]; float* out; unsigned char* ws; };
constexpr int PTAB = 131072;
__device__ __forceinline__ unsigned long long ldp_raw(LAS unsigned char* lds, int i) {
    asm volatile("" ::: "memory");
    const unsigned lo = *(volatile LAS unsigned*)(lds + PTAB + 8 * i), hi = *(volatile LAS unsigned*)(lds + PTAB + 8 * i + 4);
    return ((unsigned long long)(unsigned)__builtin_amdgcn_readfirstlane((int)hi) << 32) | (unsigned)__builtin_amdgcn_readfirstlane((int)lo);
}
#define GAS __attribute__((address_space(1)))
#define INP(i) ((const float*)(const GAS float*)ldp_raw(lds, (i)))
#define OUTP() ((float*)(GAS float*)ldp_raw(lds, 24))
#define WSP() ((unsigned char*)(GAS unsigned char*)ldp_raw(lds, 25))
#define XB_TMO      128
#define XB_XCNT(j)  (256  + 64 * (j))
#define XB_XSUB(j)  (1280 + 64 * (j))
#define XB_XGEN(j)  (2304 + 64 * (j))
#define XB_TOP      3328
#define XB_TOPGEN   3392
#define XCD_BAR_WORDS 3456
#define XB_SPIN_CAP (1u << 18)

__device__ __forceinline__ unsigned xb_ld(unsigned* p)              { return __hip_atomic_load(p, __ATOMIC_RELAXED, __HIP_MEMORY_SCOPE_AGENT); }
__device__ __forceinline__ unsigned xb_add(unsigned* p, unsigned v) { return __hip_atomic_fetch_add(p, v, __ATOMIC_RELAXED, __HIP_MEMORY_SCOPE_AGENT); }
__device__ __forceinline__ unsigned xb_xcc_id() { return (unsigned)__builtin_amdgcn_s_getreg((3 << 11) | 20) & 0xFu; }
#define XB_SPIN(cond, bar) do { unsigned _sp = 0; while (cond) { __builtin_amdgcn_s_sleep(1); \
    if ((++_sp & 255u) == 0u) { if (xb_ld(&(bar)[XB_TMO])) break; if (_sp > XB_SPIN_CAP) { atomicAdd(&(bar)[XB_TMO], 1u); break; } } } } while (0)

struct XcdBarrier {
    unsigned* bar; unsigned x;
    volatile LAS unsigned* st;
};

__device__ __forceinline__ XcdBarrier xcd_barrier_post(unsigned* bar, volatile LAS unsigned* st) {
    XcdBarrier b; b.bar = bar; b.x = xb_xcc_id(); b.st = st;
    if (threadIdx.x == 0) (void)xb_add(&bar[XB_XCNT(b.x)], 1u);
    return b;
}
__device__ __forceinline__ void xcd_barrier_complete(unsigned* bar, unsigned x, unsigned& nloc, unsigned& nx) {
    const unsigned G = gridDim.x * gridDim.y * gridDim.z;
    unsigned sum, cnt, mine, sp = 0u;
    for (;;) {
        sum = 0u; cnt = 0u; mine = 0u;
#pragma unroll
        for (unsigned j = 0; j < 16; ++j) { const unsigned c = xb_ld(&bar[XB_XCNT(j)]); sum += c; cnt += (c > 0u) ? 1u : 0u; mine = (j == x) ? c : mine; }
        if (sum == G) break;
        __builtin_amdgcn_s_sleep(1);
        if ((++sp & 255u) == 0u) { if (xb_ld(&bar[XB_TMO])) break; if (sp > XB_SPIN_CAP) { atomicAdd(&bar[XB_TMO], 1u); break; } }
    }
    nloc = mine > 0u ? mine : 1u; nx = cnt > 0u ? cnt : 1u;
}

__device__ __forceinline__ void xcd_barrier(const XcdBarrier& b) {
    asm volatile("s_waitcnt vmcnt(0)" ::: "memory");
    __syncthreads();
    if (threadIdx.x == 0) {
        unsigned* bar = b.bar;
        __builtin_amdgcn_s_waitcnt(0);
        unsigned nloc = b.st[0], nx = b.st[1];
        if (nloc == 0u) { xcd_barrier_complete(bar, b.x, nloc, nx); b.st[0] = nloc; b.st[1] = nx; }
        const unsigned old = xb_add(&bar[XB_XSUB(b.x)], 1u);
        const unsigned gen = old / nloc;
        if (old + 1u == (gen + 1u) * nloc) {
            __builtin_amdgcn_fence(__ATOMIC_RELEASE, "agent");
            asm volatile("s_waitcnt vmcnt(0)" ::: "memory");
            const unsigned og = xb_add(&bar[XB_TOP], 1u);
            const unsigned tg = og / nx;
            if (og + 1u == (tg + 1u) * nx) xb_add(&bar[XB_TOPGEN], 1u);
            else XB_SPIN(xb_ld(&bar[XB_TOPGEN]) == tg, bar);
            __builtin_amdgcn_fence(__ATOMIC_ACQUIRE, "agent");
            xb_add(&bar[XB_XGEN(b.x)], 1u);
            asm volatile("s_waitcnt vmcnt(0)" ::: "memory");
        } else {
            XB_SPIN(xb_ld(&bar[XB_XGEN(b.x)]) == gen, bar);
            __builtin_amdgcn_fence(__ATOMIC_ACQUIRE, "agent");
            asm volatile("s_waitcnt vmcnt(0)" ::: "memory");
        }
    }
    __syncthreads();
}

#define GRID_BAR() do { XcdBarrier b_; b_.bar = (unsigned*)(WSP() + WS_CTL); b_.x = xb_xcc_id(); b_.st = (volatile LAS unsigned*)(lds + PTAB + 256); xcd_barrier(b_); } while (0)

using pg8::Unit;
__device__ __forceinline__ void epi_issue_params(LAS unsigned char* lds, int wid, int lane, const float* rsq_rows  , const float* bias_lane  ) {
    LAS unsigned* slot = (LAS unsigned*)(lds + PSLOT + wid * 768);
    const float* r0 = rsq_rows + (lane >> 4) * 16 + (lane & 15);
    __builtin_amdgcn_global_load_lds((const unsigned*)r0, slot, 4, 0, 0);
    __builtin_amdgcn_global_load_lds((const unsigned*)(r0 + 128), slot + 64, 4, 0, 0);
    __builtin_amdgcn_global_load_lds((const unsigned*)bias_lane, slot + 128, 4, 0, 0);
}
template <bool HALF> struct EpiSwigluT {
    static constexpr int RM = HALF ? 128 : 256;
    static constexpr bool PREFETCH = true, PERM = true, AFTER_DRAIN = false;
    LAS unsigned char* lds; int st;
    __device__ __forceinline__ void issue(const Unit& u, int wid, int wr, int wc, int lane) const {
        unsigned char* ws = WSP(); const int l = st / 3, kind = st % 3, fq = lane >> 4, i = lane & 15;
        const float* rsq = (const float*)(ws + WS_RSQ) + (size_t)st * T + u.pm * RM + wr * 64;
        const float* bp = (const float*)(ws + WS_BIAS) + l * BIAS_L + bias_off(kind) + cond_of(u.pm * RM) * (2 * DFF) + u.pn * 256 + wc * 32 + 8 * fq + (i >> 3) * 128 + (i & 7);
        epi_issue_params(lds, wid, lane, rsq, bp);
    }
    __device__ __forceinline__ void operator()(const f32x4 (&acc)[2][2][4][2], const Unit& u, int wr, int wc, int fr, int fq) const {
        bf16* O = (bf16*)(WSP() + WS_ACT);
        const LAS float* slot = (const LAS float*)(lds + PSLOT + (wr * 4 + wc) * 768);
        const int row0 = u.pm * RM + wr * 64 + fr, col0 = u.pn * 128 + wc * 32 + 8 * fq;
        float rsv[8]; f32x4 bv[4];
#pragma unroll
        for (int k = 0; k < 8; ++k) rsv[k] = rsqrtf(slot[(k >> 2) * 64 + (k & 3) * 16 + fr] * (1.f / DM) + EPS);
#pragma unroll
        for (int k = 0; k < 4; ++k) bv[k] = *(const LAS f32x4*)(slot + 128 + fq * 16 + 4 * k);
#pragma unroll
        for (int ai = 0; ai < (HALF ? 1 : 2); ++ai)
#pragma unroll
            for (int m = 0; m < 4; ++m) {
                const int r = row0 + ai * 128 + m * 16;
                const float rs = rsv[ai * 4 + m];
                bf16* rowp = O + (size_t)r * DFF + col0;
                float v[8];
#pragma unroll
                for (int n = 0; n < 2; ++n)
#pragma unroll
                    for (int j = 0; j < 4; ++j) { const float g = acc[ai][0][m][n][j] * rs + bv[n][j], up = acc[ai][1][m][n][j] * rs + bv[2 + n][j]; v[4 * n + j] = g * fast_sigmoid(g) * up; }
                u32x4 w; w.x = pk2(v[0], v[1]); w.y = pk2(v[2], v[3]); w.z = pk2(v[4], v[5]); w.w = pk2(v[6], v[7]);
                *(u32x4*)rowp = w;
            }
    }
};
typedef EpiSwigluT<false> EpiSwiglu;
template <bool HALF> struct EpiResidT {
    static constexpr bool PREFETCH = false, PERM = true, AFTER_DRAIN = false;
    LAS unsigned char* lds; int st;
    __device__ __forceinline__ void operator()(const f32x4 (&acc)[2][2][4][2], const Unit& u, int wr, int wc, int fr, int fq) const {
        unsigned char* ws = WSP(); const int l = st / 3, kind = st % 3;
        constexpr int RM = HALF ? 128 : 256;
        float* Xo = OUTP(); const float* igs = (const float*)(ws + WS_IGS) + (size_t)st * 5 * DM;
        const float* gate = (const float*)(ws + WS_MODS) + (size_t)l * 5 * NMODV + (3 * kind + 2) * 1024; const float coef = (kind == 1) ? 1.f : 0.5f;
        bf16* H = (bf16*)(ws + WS_H); const float* gsn = (const float*)(ws + WS_GS) + (size_t)(st + 1) * 5 * DM; float* rsqn = (float*)(ws + WS_RSQ) + (size_t)(st + 1) * T;
        const int row0 = u.pm * RM + wr * 64 + fr, col0 = u.pn * 256 + wc * 32 + 8 * fq;
        const int cond = cond_of(u.pm * RM);
        const float* gp = gate + cond * NMODV;
        const bool last = (st == 5);
        f32x4 gv[2][2], sv[2][2], iv[2][2];
#pragma unroll
        for (int bj = 0; bj < 2; ++bj)
#pragma unroll
            for (int n = 0; n < 2; ++n) { gv[bj][n] = *(const f32x4*)(gp + col0 + bj * 128 + n * 4) * coef; sv[bj][n] = !last ? *(const f32x4*)(gsn + cond * DM + col0 + bj * 128 + n * 4) : (f32x4){0.f, 0.f, 0.f, 0.f};
                iv[bj][n] = *(const f32x4*)(igs + cond * DM + col0 + bj * 128 + n * 4); }
#pragma unroll
        for (int ai = 0; ai < (HALF ? 1 : 2); ++ai)
#pragma unroll
            for (int mp = 0; mp < 2; ++mp) {
                f32x4 xi[2][2][2];
                {
#pragma unroll
                    for (int mm = 0; mm < 2; ++mm)
#pragma unroll
                        for (int bj = 0; bj < 2; ++bj) { const u32x4 t = *(const u32x4*)(H + (size_t)(row0 + ai * 128 + (2 * mp + mm) * 16) * DM + col0 + bj * 128);
                            xi[mm][bj][0] = (f32x4){__builtin_bit_cast(float, t.x << 16), __builtin_bit_cast(float, t.x & 0xffff0000u), __builtin_bit_cast(float, t.y << 16), __builtin_bit_cast(float, t.y & 0xffff0000u)};
                            xi[mm][bj][1] = (f32x4){__builtin_bit_cast(float, t.z << 16), __builtin_bit_cast(float, t.z & 0xffff0000u), __builtin_bit_cast(float, t.w << 16), __builtin_bit_cast(float, t.w & 0xffff0000u)};
                            xi[mm][bj][0] = xi[mm][bj][0] * iv[bj][0]; xi[mm][bj][1] = xi[mm][bj][1] * iv[bj][1]; }
                }
#pragma unroll
                for (int mm = 0; mm < 2; ++mm) {
                    const int m = 2 * mp + mm, r = row0 + ai * 128 + m * 16;
                    const size_t ro = (size_t)r * DM + col0;
                    float ss = 0.f;
#pragma unroll
                    for (int bj = 0; bj < 2; ++bj) {
                        const f32x4 x0 = xi[mm][bj][0] + gv[bj][0] * acc[ai][bj][m][0], x1 = xi[mm][bj][1] + gv[bj][1] * acc[ai][bj][m][1];
                        if (last) { *(f32x4*)(Xo + ro + bj * 128) = x0; *(f32x4*)(Xo + ro + bj * 128 + 4) = x1; }
                        else {
                            ss += ((x0[0] * x0[0] + x0[1] * x0[1]) + (x0[2] * x0[2] + x0[3] * x0[3])) + ((x1[0] * x1[0] + x1[1] * x1[1]) + (x1[2] * x1[2] + x1[3] * x1[3]));
                            const f32x4 h0 = x0 * sv[bj][0], h1 = x1 * sv[bj][1];
                            u32x4 w; w.x = pk2(h0[0], h0[1]); w.y = pk2(h0[2], h0[3]); w.z = pk2(h1[0], h1[1]); w.w = pk2(h1[2], h1[3]); *(u32x4*)(H + ro + bj * 128) = w; } }
                    if (!last) { ss += __shfl_xor(ss, 16); ss += __shfl_xor(ss, 32); if (fq == 0) unsafeAtomicAdd(rsqn + r, ss); }
                }
            }
    }
};
typedef EpiResidT<false> EpiResid;
struct TailHalfOrder {
    int c, G;
    __device__ __forceinline__ bool next(int i, Unit& u) const { if (i != 0 || c >= 256) return false; const int xcd = c & 7, idx = c >> 3; u.pm = 128 + xcd * 8 + (idx & 7); u.pn = idx >> 3; return true; }
    __device__ __forceinline__ void a_ready(const Unit&) const {}
    __device__ __forceinline__ void done(const Unit&) const {}
};
template <bool HALF> struct EpiInProjT {
    static constexpr int RM = HALF ? 128 : 256;
    static constexpr bool PREFETCH = true, PERM = false, AFTER_DRAIN = false;
    LAS unsigned char* lds; int st;
    __device__ __forceinline__ void issue(const Unit& u, int wid, int wr, int wc, int lane) const {
        unsigned char* ws = WSP(); const int layer = st / 3, fq = lane >> 4, i = lane & 15;
        const float* rsq = (const float*)(ws + WS_RSQ) + (size_t)st * T + u.pm * RM + wr * 64;
        const float* bp = (const float*)(ws + WS_BIAS) + layer * BIAS_L + bias_off(1) + cond_of(u.pm * RM) * NIN + u.pn * 256 + wc * 32 + 4 * fq + (i >> 3) * 128 + ((i >> 2) & 1) * 16 + (i & 3);
        epi_issue_params(lds, wid, lane, rsq, bp);
    }
    __device__ __forceinline__ void operator()(const f32x4 (&acc0)[2][2][4][2], const Unit& u, int wr, int wc, int fr, int fq) const {
        unsigned char* ws = WSP(); float* out = OUTP(); const int layer = st / 3; const float* qg = INP(21) + layer * 64; const float* kg = INP(22) + layer * 64;
        const int row0 = u.pm * RM + wr * 64 + fr, pn = u.pn;
        bf16* UP = (bf16*)(ws + WS_UP); bf16* GLU = (bf16*)(ws + WS_GLU); bf16* Q = (bf16*)(ws + WS_Q); bf16* Kb = (bf16*)(ws + WS_K); bf16* Vb = (bf16*)(ws + WS_V);
        float* outK = out + (size_t)T * DM; float* outV = outK + (size_t)32 * 2 * 256 * 128; const float* rope = (const float*)(ws + WS_ROPE);
        f32x4 acc[2][2][4][2];
        {   const LAS float* slot = (const LAS float*)(lds + PSLOT + (wr * 4 + wc) * 768);
            f32x4 bv[2][2];
#pragma unroll
            for (int bj = 0; bj < 2; ++bj)
#pragma unroll
                for (int n = 0; n < 2; ++n) bv[bj][n] = *(const LAS f32x4*)(slot + 128 + fq * 16 + bj * 8 + n * 4);
#pragma unroll
            for (int ai = 0; ai < (HALF ? 1 : 2); ++ai)
#pragma unroll
                for (int m = 0; m < 4; ++m) { const float rs = rsqrtf(slot[ai * 64 + m * 16 + fr] * (1.f / DM) + EPS);
#pragma unroll
                    for (int bj = 0; bj < 2; ++bj)
#pragma unroll
                        for (int n = 0; n < 2; ++n) acc[ai][bj][m][n] = acc0[ai][bj][m][n] * rs + bv[bj][n]; } }
        if (pn == 0) {
#pragma unroll
            for (int ai = 0; ai < (HALF ? 1 : 2); ++ai)
#pragma unroll
                for (int m = 0; m < 4; ++m) { bf16* rp = UP + (size_t)(row0 + ai * 128 + m * 16) * 256 + wc * 32 + 4 * fq;
#pragma unroll
                    for (int bj = 0; bj < 2; ++bj)
#pragma unroll
                        for (int n = 0; n < 2; ++n) { const f32x4 a = acc[ai][bj][m][n]; u32x2 w; w.x = pk2(a[0], a[1]); w.y = pk2(a[2], a[3]); *(u32x2*)(rp + bj * 128 + n * 16) = w; } }
        } else if (pn <= 2) {
#pragma unroll
            for (int ai = 0; ai < (HALF ? 1 : 2); ++ai)
#pragma unroll
                for (int m = 0; m < 4; ++m) { bf16* rp = GLU + (size_t)(row0 + ai * 128 + m * 16) * 256 + (pn - 1) * 128 + wc * 32 + 4 * fq;
#pragma unroll
                    for (int n = 0; n < 2; ++n) { const f32x4 a = acc[ai][0][m][n], b = acc[ai][1][m][n]; float v[4];
#pragma unroll
                        for (int j = 0; j < 4; ++j) v[j] = a[j] * fast_sigmoid(b[j]);
                        u32x2 w; w.x = pk2(v[0], v[1]); w.y = pk2(v[2], v[3]); *(u32x2*)(rp + n * 16) = w; } }
        } else {
            const bool latent = u.pm >= TC / RM;
            if (pn == 5 && wc >= 2) {
                const int kvh = wc - 2;
#pragma unroll
                for (int ai = 0; ai < (HALF ? 1 : 2); ++ai)
#pragma unroll
                    for (int m = 0; m < 4; ++m) { const int r = row0 + ai * 128 + m * 16;
                        bf16* rp = Vb + (size_t)r * 128 + kvh * 64 + 4 * fq;
                        float* op = outV + ((size_t)((r >> 8) * 2 + layer) * 256 + (r & 255)) * 128 + kvh * 64 + 4 * fq;
#pragma unroll
                        for (int bj = 0; bj < 2; ++bj)
#pragma unroll
                            for (int n = 0; n < 2; ++n) { const f32x4 a = acc[ai][bj][m][n]; u32x2 w; w.x = pk2(a[0], a[1]); w.y = pk2(a[2], a[3]); *(u32x2*)(rp + bj * 32 + n * 16) = w;
                                if (!latent) *(f32x4*)(op + bj * 32 + n * 16) = a; } }
            } else {
                const bool isK = (pn == 5);
                const float* gam = isK ? kg : qg;
                const float qscale = isK ? 1.f : 0.125f * LOG2E;
                f32x4 gv[2][2];
#pragma unroll
                for (int bj = 0; bj < 2; ++bj)
#pragma unroll
                    for (int n = 0; n < 2; ++n) gv[bj][n] = *(const f32x4*)(gam + 32 * bj + 16 * n + 4 * fq);
#pragma unroll
                for (int ai = 0; ai < (HALF ? 1 : 2); ++ai)
#pragma unroll
                    for (int m = 0; m < 4; ++m) { const int r = row0 + ai * 128 + m * 16;
                        float ss = 0.f;
#pragma unroll
                        for (int bj = 0; bj < 2; ++bj)
#pragma unroll
                            for (int n = 0; n < 2; ++n) { const f32x4 a = acc[ai][bj][m][n]; ss += (a[0] * a[0] + a[1] * a[1]) + (a[2] * a[2] + a[3] * a[3]); }
                        ss += __shfl_xor(ss, 16); ss += __shfl_xor(ss, 32);
                        const float rstd = rsqrtf(ss * (1.f / 64.f) + EPS);
                        f32x4 val[2][2];
#pragma unroll
                        for (int bj = 0; bj < 2; ++bj)
#pragma unroll
                            for (int n = 0; n < 2; ++n) val[bj][n] = acc[ai][bj][m][n] * rstd * gv[bj][n];
                        if (isK && !latent) { float* op = outK + ((size_t)((r >> 8) * 2 + layer) * 256 + (r & 255)) * 128 + wc * 64 + 4 * fq;
#pragma unroll
                            for (int bj = 0; bj < 2; ++bj)
#pragma unroll
                                for (int n = 0; n < 2; ++n) *(f32x4*)(op + bj * 32 + n * 16) = val[bj][n]; }
                        if (latent) { const int t = (r - TC) & 4095;
#pragma unroll
                            for (int bj = 0; bj < 2; ++bj) { const int pos = bj ? (t & 63) : (t >> 6);
                                const f32x4 cs0 = *(const f32x4*)(rope + (pos * 16 + 4 * fq) * 2), cs1 = *(const f32x4*)(rope + (pos * 16 + 4 * fq) * 2 + 4);
                                const float cj[4] = {cs0[0], cs0[2], cs1[0], cs1[2]}, sj[4] = {cs0[1], cs0[3], cs1[1], cs1[3]};
#pragma unroll
                                for (int j = 0; j < 4; ++j) { const float x1 = val[bj][0][j], x2 = val[bj][1][j]; val[bj][0][j] = x1 * cj[j] - x2 * sj[j]; val[bj][1][j] = x2 * cj[j] + x1 * sj[j]; } } }
                        bf16* rp = isK ? (Kb + (size_t)r * 128 + wc * 64 + 4 * fq) : (Q + (size_t)r * 512 + ((pn - 3) * 4 + wc) * 64 + 4 * fq);
#pragma unroll
                        for (int bj = 0; bj < 2; ++bj)
#pragma unroll
                            for (int n = 0; n < 2; ++n) { const f32x4 a = val[bj][n] * qscale; u32x2 w; w.x = pk2(a[0], a[1]); w.y = pk2(a[2], a[3]); *(u32x2*)(rp + bj * 32 + n * 16) = w; } }
            }
        }
    }
};

typedef EpiInProjT<false> EpiInProj;
struct TailListOrder {
    int c, kind;
    __device__ __forceinline__ bool next(int i, Unit& u) const {
        if (i != 0 || c >= 128) return false;
        if (kind == 0) { u.pm = 176 + (c & 15); u.pn = 14 + (c >> 4); }
        else if (c < 32) { u.pm = 160 + (c & 15); u.pn = 4 + (c >> 4); }
        else { u.pm = 176 + ((c - 32) & 15); u.pn = (c - 32) >> 4; }
        return true; }
    __device__ __forceinline__ void a_ready(const Unit&) const {}
    __device__ __forceinline__ void done(const Unit&) const {}
};
__device__ __forceinline__ int map_row(int kind, int n) {
    if (kind == 1) { const int half = n >= DFF ? 1 : 0, j = n - half * DFF; return (j >> 7) * 256 + half * 128 + (j & 127); }
    if (kind == 2) {
        if (n < 256) return n;
        if (n < 768) { const int b = n >= 512 ? 1 : 0, ch = n - 256 - b * 256; return 256 * (1 + (ch >> 7)) + b * 128 + (ch & 127); }
        if (n < 1280) { const int h = (n - 768) >> 6, d = n & 63; return 256 * (3 + (h >> 2)) + 128 * (d >> 5) + 32 * (h & 3) + (d & 31); }
        { const int hh = (n - 1280) >> 6, d = n & 63; return 1280 + 128 * (d >> 5) + 32 * hh + (d & 31); }
    }
    return n;
}
__device__ __forceinline__ void p0_transpose_item(const float* W, int N, bf16* WT, int Kd, int koff, int kind, LAS float* scr, int item, int lane) {
    const int nblk = N / 32, kb = item / nblk, nb = item % nblk, k0 = 64 * kb, n0 = 32 * nb;
#pragma unroll
    for (int i = 0; i < 32; ++i) { const int kk = 2 * i + (lane >> 5); scr[kk * 33 + (lane & 31)] = __builtin_nontemporal_load(W + (size_t)(k0 + kk) * N + n0 + (lane & 31)); }
    LDS_WAIT(); asm volatile("" ::: "memory");
    const int c = lane & 7;
#pragma unroll
    for (int j = 0; j < 4; ++j) { const int n = (lane >> 3) + 8 * j; const LAS float* s = scr + (8 * c) * 33 + n;
        u32x4 o; o.x = pk2(s[0 * 33], s[1 * 33]); o.y = pk2(s[2 * 33], s[3 * 33]); o.z = pk2(s[4 * 33], s[5 * 33]); o.w = pk2(s[6 * 33], s[7 * 33]);
        *(u32x4*)(WT + (size_t)map_row(kind, n0 + n) * Kd + koff + k0 + 8 * c) = o; }
    LDS_WAIT(); asm volatile("" ::: "memory");
}

__device__ __forceinline__ void p0_prologue(LAS unsigned char* lds, int tid, int lane, int wave) {
    unsigned char* ws = WSP();
    const int G = gridDim.x, bx = blockIdx.x, gw = bx * 8 + wave, NGW = G * 8, gt = bx * NTHREADS + tid, NGT = G * NTHREADS;
    {
        LAS float* sil = (LAS float*)lds;
        { const float* cc = INP(5); const float* cl = INP(4);
        for (int i = tid; i < 5 * 1024; i += NTHREADS) { const int c = i >> 10, k = i & 1023; const float v = (c == 0) ? cc[k] : cl[(c - 1) * 1024 + k]; sil[i] = v * fast_sigmoid(v); } }
        __syncthreads();
        float* mods = (float*)(ws + WS_MODS); const float* modw = INP(6); const float* modb = INP(7);
        for (int it = gw; it < 9216; it += NGW) {
            const int l = it / 4608, rem = it % 4608, jb = rem >> 5, kc = rem & 31;
            const float* wp = modw + ((size_t)l * 1024 + kc * 32) * NMODV + jb * 64 + lane;
            float wv[32];
#pragma unroll
            for (int k = 0; k < 32; ++k) wv[k] = __builtin_nontemporal_load(wp + (size_t)k * NMODV);
            float a0 = 0.f, a1 = 0.f, a2 = 0.f, a3 = 0.f, a4 = 0.f;
#pragma unroll
            for (int k = 0; k < 32; ++k) { const float w = wv[k]; const int kk = kc * 32 + k; if ((k & 7) == 0) __builtin_amdgcn_sched_barrier(0);
                a0 += sil[kk] * w; a1 += sil[1024 + kk] * w; a2 += sil[2048 + kk] * w; a3 += sil[3072 + kk] * w; a4 += sil[4096 + kk] * w; }
            if (kc == 0) { const float bb = modb[l * NMODV + jb * 64 + lane]; a0 += bb; a1 += bb; a2 += bb; a3 += bb; a4 += bb; }
            float* mp = mods + (size_t)(l * 5) * NMODV + jb * 64 + lane;
            unsafeAtomicAdd(mp, a0); unsafeAtomicAdd(mp + NMODV, a1); unsafeAtomicAdd(mp + 2 * NMODV, a2); unsafeAtomicAdd(mp + 3 * NMODV, a3); unsafeAtomicAdd(mp + 4 * NMODV, a4);
        }
    }
    if (gt < 1024) { const int pos = gt >> 4, i = gt & 15; const float inv = exp2f(-(float)i * (13.287712379549449f / 16.f)); float s, c; sincosf((float)pos * inv, &s, &c);
        float* rope = (float*)(ws + WS_ROPE); rope[gt * 2] = c; rope[gt * 2 + 1] = s; }
    __syncthreads();
    { const f32x4* ck = (const f32x4*)INP(2); const f32x4* cv = (const f32x4*)INP(3); u32x2* ok = (u32x2*)(ws + WS_CK); u32x2* ov = (u32x2*)(ws + WS_CV);
        for (int i = gt; i < 4 * 2 * 512 * 128 / 4; i += NGT) { const f32x4 a = ck[i], b = cv[i]; u32x2 w; w.x = pk2(a[0], a[1]); w.y = pk2(a[2], a[3]); ok[i] = w; w.x = pk2(b[0], b[1]); w.y = pk2(b[2], b[3]); ov[i] = w; } }
    {
        LAS float* scr = (LAS float*)(lds + wave * 16384);
        constexpr int I_WI = 16 * 176, I_WO = 44 * 32, I_IN = 16 * 48, I_OUT = 8 * 32, I_L = 2 * I_WI + 2 * I_WO + I_IN + I_OUT;
        for (int it = gw; it < 2 * I_L; it += NGW) {
            const int l = it / I_L; int r = it % I_L; bf16* wb = (bf16*)(ws + WS_W + (size_t)l * W_LAYER);
            if (r < I_WI) { p0_transpose_item(INP(9) + (size_t)l * DM * 2 * DFF, 2 * DFF, (bf16*)((unsigned char*)wb + W_WI1), DM, 0, 1, scr, r, lane); continue; } r -= I_WI;
            if (r < I_WI) { p0_transpose_item(INP(11) + (size_t)l * DM * 2 * DFF, 2 * DFF, (bf16*)((unsigned char*)wb + W_WI2), DM, 0, 1, scr, r, lane); continue; } r -= I_WI;
            if (r < I_WO) { p0_transpose_item(INP(10) + (size_t)l * DFF * DM, DM, (bf16*)((unsigned char*)wb + W_WO1), DFF, 0, 0, scr, r, lane); continue; } r -= I_WO;
            if (r < I_WO) { p0_transpose_item(INP(12) + (size_t)l * DFF * DM, DM, (bf16*)((unsigned char*)wb + W_WO2), DFF, 0, 0, scr, r, lane); continue; } r -= I_WO;
            if (r < I_IN) { p0_transpose_item(INP(13) + (size_t)l * DM * NIN, NIN, (bf16*)((unsigned char*)wb + W_WIN), DM, 0, 2, scr, r, lane); continue; } r -= I_IN;
            p0_transpose_item(INP(14) + (size_t)l * DM * DM + (size_t)512 * DM, DM, (bf16*)((unsigned char*)wb + W_WOUT), DM, 512, 0, scr, r, lane);
        }
    }
    {
        LAS float* pws = (LAS float*)(lds + wave * 16384);
        for (int it = gw; it < 1024; it += NGW) {
            const int l = it >> 9, rb = (it >> 4) & 31, nb = it & 15, r0 = 16 * rb, n = nb * 64 + lane;
            const float* wo = INP(14) + (size_t)l * DM * DM;
            const bool pool = r0 < 256; const int KC = pool ? 64 : 256;
            const float* wrow;
            if (pool) { const int j = r0 >> 6; const float* pw = INP(15) + (size_t)(l * 4 + j) * 4096 + (r0 & 63) * 64; const float ps = INP(16)[l * 256 + 64 * j + lane]; wrow = wo + (size_t)(64 * j) * DM + n;
#pragma unroll
                for (int i = 0; i < 16; ++i) pws[i * 256 + lane] = pw[i * 64 + lane] * ps; }
            else { const float* pw = INP(20) + (size_t)l * 65536 + (size_t)(r0 - 256) * 256; wrow = wo + (size_t)256 * DM + n;
#pragma unroll
                for (int i = 0; i < 16; ++i) *(LAS f32x4*)(pws + i * 256 + lane * 4) = *(const f32x4*)(pw + i * 256 + lane * 4); }
            LDS_WAIT(); asm volatile("" ::: "memory");
            float a[16];
#pragma unroll
            for (int i = 0; i < 16; ++i) a[i] = 0.f;
#pragma unroll 1
            for (int c0 = 0; c0 < KC; c0 += 16) {
                float w[16];
#pragma unroll
                for (int q = 0; q < 16; ++q) w[q] = wrow[(size_t)(c0 + q) * DM];
#pragma unroll
                for (int q4 = 0; q4 < 4; ++q4) {
#pragma unroll
                    for (int i = 0; i < 16; ++i) { const f32x4 pv = *(const LAS f32x4*)(pws + i * 256 + c0 + 4 * q4); a[i] += pv[0] * w[4 * q4] + pv[1] * w[4 * q4 + 1] + pv[2] * w[4 * q4 + 2] + pv[3] * w[4 * q4 + 3]; }
                }
            }
            bf16* wt = (bf16*)(ws + WS_W + (size_t)l * W_LAYER + W_WOUT) + (size_t)n * DM + r0;
            u32x4 w0, w1; w0.x = pk2(a[0], a[1]); w0.y = pk2(a[2], a[3]); w0.z = pk2(a[4], a[5]); w0.w = pk2(a[6], a[7]); w1.x = pk2(a[8], a[9]); w1.y = pk2(a[10], a[11]); w1.z = pk2(a[12], a[13]); w1.w = pk2(a[14], a[15]);
            *(u32x4*)wt = w0; *(u32x4*)(wt + 8) = w1;
            LDS_WAIT(); asm volatile("" ::: "memory");
        }
    }
}

__device__ __forceinline__ void bias_compute(int l, int gw, int NGW, LAS unsigned char* lds, int lane) {
    unsigned char* ws = WSP(); const float* mods = (const float*)(ws + WS_MODS);
#pragma unroll 1
    for (int kind = 0; kind < 3; ++kind) {
        const int N = (kind == 1) ? NIN : 2 * DFF;
        const bf16* Bt = (const bf16*)(ws + WS_W + (size_t)l * W_LAYER + (kind == 0 ? W_WI1 : (kind == 1 ? W_WIN : W_WI2)));
        float* bo = (float*)(ws + WS_BIAS) + l * BIAS_L + bias_off(kind);
        float sh[5][16];
#pragma unroll
        for (int c = 0; c < 5; ++c)
#pragma unroll
            for (int q = 0; q < 4; ++q) { const f32x4 t = *(const f32x4*)(mods + (size_t)(l * 5 + c) * NMODV + (3 * kind) * 1024 + lane * 16 + 4 * q); sh[c][4 * q] = t[0]; sh[c][4 * q + 1] = t[1]; sh[c][4 * q + 2] = t[2]; sh[c][4 * q + 3] = t[3]; }
        for (int n = gw; n < N; n += NGW) {
            const u32x4 w0 = *(const u32x4*)(Bt + (size_t)n * DM + lane * 16), w1 = *(const u32x4*)(Bt + (size_t)n * DM + lane * 16 + 8);
            const unsigned wv[8] = {w0.x, w0.y, w0.z, w0.w, w1.x, w1.y, w1.z, w1.w};
            float d[5] = {0.f, 0.f, 0.f, 0.f, 0.f};
#pragma unroll
            for (int e = 0; e < 8; ++e) { const float lo = __builtin_bit_cast(float, wv[e] << 16), hi = __builtin_bit_cast(float, wv[e] & 0xffff0000u);
#pragma unroll
                for (int c = 0; c < 5; ++c) d[c] += sh[c][2 * e] * lo + sh[c][2 * e + 1] * hi; }
#pragma unroll
            for (int c = 0; c < 5; ++c) { const float t = wave_sum(d[c]); if (lane == 0) bo[c * N + n] = t; }
        }
    }
}

__device__ __forceinline__ void n0_phase(LAS unsigned char* lds, int tid, int lane, int wave) {
    unsigned char* ws = WSP();
    const int G = gridDim.x, bx = blockIdx.x, gw = bx * 8 + wave, NGW = G * 8, gt = bx * NTHREADS + tid, NGT = G * NTHREADS;
    const float* mods = (const float*)(ws + WS_MODS);
    {   const float* ngp = INP(8); float* gs = (float*)(ws + WS_GS);
        for (int i = gt; i < 2 * 3 * 5 * 1024; i += NGT) { const int k = i & 1023, c = (i >> 10) % 5, lk = i / 5120, l = lk / 3, kind = lk % 3;
            const float gsv = ngp[(size_t)(l * 3 + kind) * DM + k] * (1.f + mods[(size_t)(l * 5 + c) * NMODV + (3 * kind + 1) * 1024 + k]);
            gs[i] = gsv; ((float*)(ws + WS_IGS))[i] = (fabsf(gsv) > 1e-30f) ? 1.f / gsv : 0.f; } }
    {   const float* ngp = INP(8); const float* xa = INP(0); const float* xb = INP(1) - (size_t)TC * DM; bf16* H = (bf16*)(ws + WS_H); float* rsq = (float*)(ws + WS_RSQ);
        for (int r0 = gw; r0 < T; r0 += 2 * NGW) {
            const int r1 = r0 + NGW; const bool has1 = r1 < T;
            const float* xr0 = (r0 < TC ? xa : xb) + (size_t)r0 * DM; const float* xr1 = has1 ? (r1 < TC ? xa : xb) + (size_t)r1 * DM : xr0;
            f32x4 v0[4], v1[4];
#pragma unroll
            for (int j = 0; j < 4; ++j) v0[j] = __builtin_nontemporal_load((const f32x4*)xr0 + lane + 64 * j);
#pragma unroll
            for (int j = 0; j < 4; ++j) v1[j] = __builtin_nontemporal_load((const f32x4*)xr1 + lane + 64 * j);
#pragma unroll
            for (int h = 0; h < 2; ++h) { if (h == 1 && !has1) break;
                const int r = h ? r1 : r0; const f32x4* v = h ? v1 : v0;
                const float* mp = mods + cond_of(r) * NMODV + 1024;
                float s = 0.f;
#pragma unroll
                for (int j = 0; j < 4; ++j) s += (v[j][0] * v[j][0] + v[j][1] * v[j][1]) + (v[j][2] * v[j][2] + v[j][3] * v[j][3]);
                s = wave_sum(s);
                if (lane == 0) rsq[r] = s;
#pragma unroll
                for (int j = 0; j < 4; ++j) { const int c = 4 * (lane + 64 * j);
                    const f32x4 g = *(const f32x4*)(ngp + c), sc = *(const f32x4*)(mp + c);
                    const f32x4 y = v[j] * g * (sc + 1.f);
                    u32x2 w; w.x = pk2(y[0], y[1]); w.y = pk2(y[2], y[3]); *(u32x2*)(H + (size_t)r * DM + c) = w; } }
        }
    }
    bias_compute(0, gw, NGW, lds, lane);
    if (G != 256) bias_compute(1, gw, NGW, lds, lane);
}

__device__ __forceinline__ void poolconv_units(int pc0, int npc, unsigned char* ws, const float* dwl, const float* dbl, const float* cngl, LAS unsigned char* lds, int tid, int lane, int wave) {
    constexpr int GS = 0, US = 31744, YS = 56320;
    const bf16* UP = (const bf16*)(ws + WS_UP); const bf16* GLU = (const bf16*)(ws + WS_GLU); bf16* MIX = (bf16*)(ws + WS_MIX);
    const int c = tid & 255, half = tid >> 8;
    const int srow = tid >> 5, sch = tid & 31;
    u32x4 sg[4], su[3];
#define PC_BOUNDS(PC) const int m0 = (PC) * 32; int s_lo, s_hi; if (m0 < TC) { s_lo = m0 & ~255; s_hi = s_lo + 256; } else { s_lo = TC + ((m0 - TC) & ~4095); s_hi = s_lo + 4096; }
#define PC_LOAD(PC) do { PC_BOUNDS(PC) \
        _Pragma("unroll") for (int i = 0; i < 4; ++i) { const int row = srow + 16 * i, gr = m0 - 15 + row; sg[i] = (u32x4){0u, 0u, 0u, 0u}; if (row < 62 && gr >= s_lo && gr < s_hi) sg[i] = *(const u32x4*)(GLU + (size_t)gr * 256 + sch * 8); } \
        _Pragma("unroll") for (int i = 0; i < 3; ++i) { const int row = srow + 16 * i, gr = m0 - 8 + row; su[i] = (u32x4){0u, 0u, 0u, 0u}; if (gr >= s_lo && gr < s_hi) su[i] = *(const u32x4*)(UP + (size_t)gr * 256 + sch * 8); } } while (0)
    PC_LOAD(pc0);
    const float bias = dbl[c];
    const f32x4 g4 = *(const f32x4*)(cngl + lane * 4);
#pragma unroll 1
    for (int k = 0; k < npc; ++k) {
        PC_BOUNDS(pc0 + k)
        LDS_BARRIER();
#pragma unroll
        for (int i = 0; i < 4; ++i) { const int row = srow + 16 * i; if (row < 62) *(LAS u32x4*)(lds + GS + row * 512 + sch * 16) = sg[i]; }
#pragma unroll
        for (int i = 0; i < 3; ++i) { const int row = srow + 16 * i; *(LAS u32x4*)(lds + US + row * 512 + sch * 16) = su[i]; }
        LDS_BARRIER();
        if (k + 1 < npc) PC_LOAD(pc0 + k + 1);
        {
            float dw[31];
#pragma unroll
            for (int j = 0; j < 31; ++j) dw[j] = dwl[j * 256 + c];
            float y[16];
#pragma unroll
            for (int o = 0; o < 16; ++o) y[o] = bias;
#pragma unroll
            for (int i = 0; i < 46; ++i) { const float v = bf2f(*(const LAS bf16*)(lds + GS + (16 * half + i) * 512 + c * 2));
#pragma unroll
                for (int o = 0; o < 16; ++o) { const int j = i - o; if (j >= 0 && j <= 30) y[o] += v * dw[j]; } }
#pragma unroll
            for (int o = 0; o < 16; ++o) *(LAS float*)(lds + YS + ((16 * half + o) * 256 + c) * 4) = y[o];
        }
        {
            const int jg = c >> 6;
            float pv[33]; pv[0] = 0.f;
#pragma unroll
            for (int i = 0; i < 32; ++i) pv[i + 1] = pv[i] + bf2f(*(const LAS bf16*)(lds + US + (16 * half + i) * 512 + c * 2));
#define POOL_BODY(W2) _Pragma("unroll") for (int o = 0; o < 16; ++o) { const int gm = m0 + 16 * half + o; int lo = gm - (W2), hi = gm + (W2); lo = lo < s_lo ? s_lo : lo; hi = hi > s_hi ? s_hi : hi; \
                const float self = pv[o + 9] - pv[o + 8]; const float pooled = (pv[o + 8 + (W2)] - pv[o + 8 - (W2)]) * __builtin_amdgcn_rcpf((float)(hi - lo)) - self; \
                MIX[(size_t)gm * DM + c] = (bf16)(pk2(pooled, 0.f) & 0xffffu); }
            if (jg == 0) { POOL_BODY(1) } else if (jg == 1) { POOL_BODY(2) } else if (jg == 2) { POOL_BODY(4) } else { POOL_BODY(8) }
#undef POOL_BODY
        }
        LDS_BARRIER();
#pragma unroll
        for (int tk = 0; tk < 4; ++tk) { const int tl = wave * 4 + tk;
            const f32x4 v = *(const LAS f32x4*)(lds + YS + (tl * 256 + lane * 4) * 4);
            const float ss = wave_sum((v[0] * v[0] + v[1] * v[1]) + (v[2] * v[2] + v[3] * v[3]));
            const float rstd = rsqrtf(ss * (1.f / 256.f) + EPS);
            f32x4 z = v * rstd * g4;
#pragma unroll
            for (int j = 0; j < 4; ++j) z[j] = z[j] * fast_sigmoid(z[j]);
            u32x2 w; w.x = pk2(z[0], z[1]); w.y = pk2(z[2], z[3]); *(u32x2*)(MIX + (size_t)(m0 + tl) * DM + 256 + lane * 4) = w; }
    }
#undef PC_LOAD
#undef PC_BOUNDS
}

#define MFMA32(a, b, c) __builtin_amdgcn_mfma_f32_32x32x16_bf16((a), (b), (c), 0, 0, 0)
__device__ __forceinline__ float max3f(float a, float b, float c) { float r; asm("v_max3_f32 %0, %1, %2, %3" : "=v"(r) : "v"(a), "v"(b), "v"(c)); return r; }
__device__ __forceinline__ void attn_unit(int au, int layer, unsigned char* ws, const float* sink_l, LAS unsigned char* lds, int tid, int lane, int wave) {
    constexpr int KS = 0, VS = 9216;
    const bf16* Qb = (const bf16*)(ws + WS_Q); const bf16* Kb = (const bf16*)(ws + WS_K); const bf16* Vb = (const bf16*)(ws + WS_V); const bf16* CK = (const bf16*)(ws + WS_CK); const bf16* CV = (const bf16*)(ws + WS_CV); bf16* MIX = (bf16*)(ws + WS_MIX);
    int rb, q0, kvh, nwin, wk0, nctx, cb; bool latent;
    if (au < 256) { latent = true; const int b = au >> 6, rem = au & 63; kvh = rem >> 5; const int qblk = rem & 31; rb = TC + b * 4096; q0 = qblk * 128;
        int lo = q0 - 128; if (lo < 0) lo = 0; int hi = q0 + 256; if (hi > 4096) hi = 4096; wk0 = lo; nwin = (hi - lo) >> 6; nctx = 8; cb = (b * 2 + layer) * 512; }
    else { latent = false; const int cu = au - 256, b = cu >> 2; kvh = (cu >> 1) & 1; const int qblk = cu & 1; rb = b * 256; q0 = qblk * 128; wk0 = 0; nwin = 4; nctx = 0; cb = 0; }
    const int nt = nwin + nctx;
    const int g = wave >> 1, rhalf = wave & 1, h = kvh * 4 + g, l31 = lane & 31, hf = lane >> 5;
    bf16x8 qf[2][4];
#pragma unroll
    for (int qb = 0; qb < 2; ++qb)
#pragma unroll
        for (int kk = 0; kk < 4; ++kk) qf[qb][kk] = *(const bf16x8*)(Qb + (size_t)(rb + q0 + 64 * rhalf + 32 * qb + l31) * 512 + h * 64 + 16 * kk + 8 * hf);
    const float sk = sink_l[h] * LOG2E;
    float mrow[2] = {sk, sk}, ls[2] = {0.f, 0.f};
    f32x16 O[2][2];
#pragma unroll
    for (int a = 0; a < 2; ++a)
#pragma unroll
        for (int b = 0; b < 2; ++b)
#pragma unroll
            for (int i = 0; i < 16; ++i) O[a][b][i] = 0.f;
    const int skey = tid >> 3, sdc = tid & 7;
#define ATT_LOAD(TI, KR, VR) do { const int t_ = (TI); if (t_ < nt) { \
        const bf16* kp_ = (t_ < nwin) ? Kb + (size_t)(rb + wk0 + 64 * t_ + skey) * 128 + kvh * 64 + sdc * 8 : CK + (size_t)(cb + 64 * (t_ - nwin) + skey) * 128 + kvh * 64 + sdc * 8; \
        const bf16* vp_ = (t_ < nwin) ? Vb + (size_t)(rb + wk0 + 64 * t_ + skey) * 128 + kvh * 64 + sdc * 8 : CV + (size_t)(cb + 64 * (t_ - nwin) + skey) * 128 + kvh * 64 + sdc * 8; \
        KR = *(const u32x4*)kp_; VR = *(const u32x4*)vp_; } } while (0)
    u32x4 kreg = {0u, 0u, 0u, 0u}, vreg = kreg, kr1 = kreg, vr1 = kreg, kr2 = kreg, vr2 = kreg;
    ATT_LOAD(0, kreg, vreg); ATT_LOAD(1, kr1, vr1); ATT_LOAD(2, kr2, vr2);
    for (int ti = 0; ti < nt; ++ti) {
        LDS_BARRIER();
        *(LAS u32x4*)(lds + KS + skey * 144 + sdc * 16) = kreg;
        {   const unsigned vv[4] = {vreg.x, vreg.y, vreg.z, vreg.w};
#pragma unroll
            for (int j = 0; j < 8; ++j) *(LAS bf16*)(lds + VS + (sdc * 8 + j) * 136 + skey * 2) = (bf16)((vv[j >> 1] >> ((j & 1) * 16)) & 0xffffu); }
        LDS_BARRIER();
        const bool win = ti < nwin;
        const int k0 = wk0 + 64 * ti;
        kreg = kr1; vreg = vr1; kr1 = kr2; vr1 = vr2;
        ATT_LOAD(ti + 3, kr2, vr2);
        const int rel = k0 - (q0 + 64 * rhalf);
        const bool domask = latent && win && (rel > 64 || rel < -64);
        if (latent && win && (rel > 128 || rel < -128)) continue;
#define ATT_QK(S0, S1, QB) do { const float nm_ = -mrow[QB];     \
            const f32x16 Z_ = {nm_, nm_, nm_, nm_, nm_, nm_, nm_, nm_, nm_, nm_, nm_, nm_, nm_, nm_, nm_, nm_}; \
            { const bf16x8 a0 = *(const LAS bf16x8*)(lds + KS + l31 * 144 + (8 * hf) * 2); const bf16x8 a1 = *(const LAS bf16x8*)(lds + KS + (32 + l31) * 144 + (8 * hf) * 2); \
              S0 = MFMA32(a0, qf[QB][0], Z_); S1 = MFMA32(a1, qf[QB][0], Z_); } \
            _Pragma("unroll") for (int kk = 1; kk < 4; ++kk) { \
                const bf16x8 a0 = *(const LAS bf16x8*)(lds + KS + l31 * 144 + (16 * kk + 8 * hf) * 2); const bf16x8 a1 = *(const LAS bf16x8*)(lds + KS + (32 + l31) * 144 + (16 * kk + 8 * hf) * 2); \
                S0 = MFMA32(a0, qf[QB][kk], S0); S1 = MFMA32(a1, qf[QB][kk], S1); } } while (0)
#define ATT_SM(S0, S1, QB) do { \
            if (domask) { const int qpos = q0 + 64 * rhalf + 32 * (QB) + l31; \
                _Pragma("unroll") for (int i = 0; i < 16; ++i) { const int d0 = qpos - (k0 + 8 * (i >> 2) + 4 * hf + (i & 3)); const int d1 = d0 - 32; \
                    if (d0 > 128 || d0 < -128) S0[i] = -1e30f; if (d1 > 128 || d1 < -128) S1[i] = -1e30f; } } \
            float mx = max3f(0.f, S0[0], S1[0]); \
            _Pragma("unroll") for (int i = 1; i < 16; ++i) mx = max3f(mx, S0[i], S1[i]); \
            const float dl = max3f(mx, mx, __shfl_xor(mx, 32));     \
            if (__builtin_amdgcn_ballot_w64(dl > 8.f) != 0ull) {     \
                const float alpha = __builtin_amdgcn_exp2f(-dl); mrow[QB] += dl; ls[QB] *= alpha; \
                S0 = S0 - dl; S1 = S1 - dl; \
                _Pragma("unroll") for (int i = 0; i < 16; ++i) { O[0][QB][i] *= alpha; O[1][QB][i] *= alpha; } } \
            _Pragma("unroll") for (int i = 0; i < 16; ++i) { S0[i] = __builtin_amdgcn_exp2f(S0[i]); S1[i] = __builtin_amdgcn_exp2f(S1[i]); } \
            {   const f32x16 t16 = S0 + S1; typedef float f32x8 __attribute__((ext_vector_type(8))); \
                const f32x8 t8 = __builtin_shufflevector(t16, t16, 0, 1, 2, 3, 4, 5, 6, 7) + __builtin_shufflevector(t16, t16, 8, 9, 10, 11, 12, 13, 14, 15); \
                const f32x4 t4 = __builtin_shufflevector(t8, t8, 0, 1, 2, 3) + __builtin_shufflevector(t8, t8, 4, 5, 6, 7); \
                ls[QB] += (t4[0] + t4[1]) + (t4[2] + t4[3]); } } while (0)
#define ATT_PV(S0, S1, QB) do { bf16x8 pf[2][2]; \
            _Pragma("unroll") for (int a = 0; a < 2; ++a) { \
                u32x4 w0; w0.x = pk2(S0[8 * a], S0[8 * a + 1]); w0.y = pk2(S0[8 * a + 2], S0[8 * a + 3]); w0.z = pk2(S0[8 * a + 4], S0[8 * a + 5]); w0.w = pk2(S0[8 * a + 6], S0[8 * a + 7]); \
                u32x4 w1; w1.x = pk2(S1[8 * a], S1[8 * a + 1]); w1.y = pk2(S1[8 * a + 2], S1[8 * a + 3]); w1.z = pk2(S1[8 * a + 4], S1[8 * a + 5]); w1.w = pk2(S1[8 * a + 6], S1[8 * a + 7]); \
                pf[0][a] = __builtin_bit_cast(bf16x8, w0); pf[1][a] = __builtin_bit_cast(bf16x8, w1); } \
            _Pragma("unroll") for (int db = 0; db < 2; ++db) _Pragma("unroll") for (int kb = 0; kb < 2; ++kb) _Pragma("unroll") for (int a = 0; a < 2; ++a) { const int Gk = 32 * kb + 16 * a; \
                const u32x2 lo8 = *(const LAS u32x2*)(lds + VS + (32 * db + l31) * 136 + (Gk + 4 * hf) * 2); const u32x2 hi8 = *(const LAS u32x2*)(lds + VS + (32 * db + l31) * 136 + (Gk + 8 + 4 * hf) * 2); \
                u32x4 av; av.x = lo8.x; av.y = lo8.y; av.z = hi8.x; av.w = hi8.y; \
                O[db][QB] = MFMA32(__builtin_bit_cast(bf16x8, av), pf[kb][a], O[db][QB]); } } while (0)
        {
            f32x16 Sa0, Sa1, Sb0, Sb1;
            __builtin_amdgcn_sched_barrier(0);
            ATT_QK(Sa0, Sa1, 0);
            ATT_QK(Sb0, Sb1, 1);
            __builtin_amdgcn_sched_barrier(0);
            ATT_SM(Sa0, Sa1, 0);
            __builtin_amdgcn_sched_barrier(0);
            ATT_PV(Sa0, Sa1, 0);
            __builtin_amdgcn_sched_barrier(0);
            ATT_SM(Sb0, Sb1, 1);
            __builtin_amdgcn_sched_barrier(0);
            ATT_PV(Sb0, Sb1, 1);
        }
#undef ATT_QK
#undef ATT_SM
#undef ATT_PV
#undef ATT_LOAD
    }
#pragma unroll
    for (int qb = 0; qb < 2; ++qb) {
        const float lt = ls[qb] + __shfl_xor(ls[qb], 32) + __builtin_amdgcn_exp2f(sk - mrow[qb]);
        const float inv = 1.f / lt;
        bf16* rp = MIX + (size_t)(rb + q0 + 64 * rhalf + 32 * qb + l31) * DM + 512 + h * 64 + 4 * hf;
#pragma unroll
        for (int db = 0; db < 2; ++db)
#pragma unroll
            for (int g4 = 0; g4 < 4; ++g4) { u32x2 w; w.x = pk2(O[db][qb][4 * g4] * inv, O[db][qb][4 * g4 + 1] * inv); w.y = pk2(O[db][qb][4 * g4 + 2] * inv, O[db][qb][4 * g4 + 3] * inv);
                *(u32x2*)(rp + 32 * db + 8 * g4) = w; }
    }
}

__global__ void __launch_bounds__(NTHREADS, 2) fwd_kernel(Params p) {
    extern __shared__ __attribute__((aligned(16))) unsigned char lds_raw[];
    cg::grid_group grid = cg::this_grid();
    LAS unsigned char* lds = (LAS unsigned char*)lds_raw;
#define PHASE_IDS() int tid = threadIdx.x; asm volatile("" : "+v"(tid)); const int lane = tid & 63, wave = __builtin_amdgcn_readfirstlane(tid >> 6); (void)lane; (void)wave
    { PHASE_IDS();
    if (tid < 26) { const unsigned long long __attribute__((address_space(4)))* ka = (const unsigned long long __attribute__((address_space(4)))*)__builtin_amdgcn_kernarg_segment_ptr();
        *(LAS unsigned long long*)(lds + PTAB + 8 * tid) = ka[tid]; }
    if (tid < 2) *(LAS unsigned*)(lds + PTAB + 256 + 4 * tid) = 0u;
    __syncthreads();
    (void)xcd_barrier_post((unsigned*)(WSP() + WS_CTL), (volatile LAS unsigned*)(lds + PTAB + 256));
    if (gridDim.x > 1000000u) grid.sync();
#ifndef NO_P0
    p0_prologue(lds, tid, lane, wave);
#endif
    }
    GRID_BAR();
    { PHASE_IDS(); n0_phase(lds, tid, lane, wave); }
    GRID_BAR();

#pragma unroll 1
    for (int st = 0; st < 6; ++st) {
        const int l = st / 3, kind = st % 3;
        if (kind == 1) {
            {   const int G = gridDim.x, bx = blockIdx.x; unsigned char* ws = WSP();
                pg8::Gemm g{(const bf16*)(ws + WS_H), (const bf16*)(ws + WS_W + (size_t)l * W_LAYER + W_WIN), T, NIN, DM}; pg8::StaticOrder S; S.init(T, NIN, G, bx);
                EpiInProj E{lds, st};
                pg8::gemm_phase<EpiInProj, pg8::StaticOrder, true, true>(lds, g, S, E);
            }
            GRID_BAR();
#ifndef NO_ATTN
            {   PHASE_IDS(); const int G = gridDim.x, bx = blockIdx.x;
                if (G == 256) {
                    attn_unit((bx & 7) * 32 + (bx >> 3), l, WSP(), INP(23) + l * 8, lds, tid, lane, wave);
                    if (bx < 128) attn_unit(256 + (bx & 7) * 16 + (bx >> 3), l, WSP(), INP(23) + l * 8, lds, tid, lane, wave); }
                else for (int it = bx; it < 384; it += G) attn_unit(it, l, WSP(), INP(23) + l * 8, lds, tid, lane, wave); }
#endif
#ifndef NO_PC
            {   PHASE_IDS(); const int G = gridDim.x, bx = blockIdx.x;
                if (G == 256) { const int npc = bx < 128 ? 2 : 4, pc0 = bx < 128 ? 2 * bx : 256 + 4 * (bx - 128);
                    poolconv_units(pc0, npc, WSP(), INP(17) + (size_t)l * 31 * 256, INP(18) + l * 256, INP(19) + l * 256, lds, tid, lane, wave); }
                else for (int it = bx; it < 768; it += G) poolconv_units(it, 1, WSP(), INP(17) + (size_t)l * 31 * 256, INP(18) + l * 256, INP(19) + l * 256, lds, tid, lane, wave); }
#endif
        } else {
            const int G = gridDim.x, bx = blockIdx.x; unsigned char* ws = WSP();
            pg8::Gemm g{(const bf16*)(ws + WS_H), (const bf16*)(ws + WS_W + (size_t)l * W_LAYER + (kind == 0 ? W_WI1 : W_WI2)), T, 2 * DFF, DM}; pg8::StaticOrder S; S.init(T, 2 * DFF, G, bx); const bool split = (G == 256); if (split) S.nwg = 2048;
            EpiSwiglu E{lds, st};
            pg8::gemm_phase<EpiSwiglu, pg8::StaticOrder, true, true>(lds, g, S, E);
            if (split) { TailListOrder S2{bx, 0}; EpiSwigluT<true> E2{lds, st}; pg8::gemm_phase<EpiSwigluT<true>, TailListOrder, true, true, true>(lds, g, S2, E2); }
            if (st == 0 && split && bx >= 128) { PHASE_IDS(); bias_compute(1, (bx - 128) * 8 + wave, 128 * 8, lds, lane); }
        }
        GRID_BAR();
        {   const int G = gridDim.x, bx = blockIdx.x; unsigned char* ws = WSP();
            const bf16* A = (const bf16*)(ws + ((kind == 1) ? WS_MIX : WS_ACT)); const int K = (kind == 1) ? DM : DFF;
            const bf16* B = (const bf16*)(ws + WS_W + (size_t)l * W_LAYER + (kind == 0 ? W_WO1 : (kind == 1 ? W_WOUT : W_WO2)));
            pg8::Gemm g{A, B, T, DM, K, 0, 0}; pg8::StaticOrder S; S.init(T, DM, G, bx); const bool split = (G == 256); if (split) S.nwg = 256;
            EpiResid E{lds, st};
#ifndef NO_G2
            pg8::gemm_phase<EpiResid, pg8::StaticOrder, RESID_ALIGN, true, false>(lds, g, S, E);
            if (split) { TailHalfOrder S2{bx, G}; EpiResidT<true> E2{lds, st}; pg8::gemm_phase<EpiResidT<true>, TailHalfOrder, RESID_ALIGN, true, true>(lds, g, S2, E2); }
#endif
        }
        if (st != 5) GRID_BAR();
    }
}

extern "C" void kernel_launch(void* const* d_in, const int* in_sizes, int n_in, void* d_out, int out_size, void* d_ws, size_t ws_size, hipStream_t stream) {
    static int grid = 0;
    if (grid == 0) {
        if (n_in != 24 || ws_size < WS_END) { fprintf(stderr, "kernel_launch: unexpected n_in %d / ws_size %zu\n", n_in, ws_size); grid = -1; return; }
        int dev = 0, cus = 0, per_cu = 0;
        hipGetDevice(&dev); hipDeviceGetAttribute(&cus, hipDeviceAttributeMultiprocessorCount, dev);
        if (hipFuncSetAttribute((const void*)fwd_kernel, hipFuncAttributeMaxDynamicSharedMemorySize, LDS_BYTES) != hipSuccess) { fprintf(stderr, "kernel_launch: hipFuncSetAttribute failed\n"); grid = -1; return; }
        if (hipOccupancyMaxActiveBlocksPerMultiprocessor(&per_cu, (const void*)fwd_kernel, NTHREADS, LDS_BYTES) != hipSuccess || per_cu < 1) { fprintf(stderr, "kernel_launch: occupancy query says %d\n", per_cu); per_cu = 1; }
        (void)hipGetLastError();
        grid = cus * (per_cu > 1 ? 1 : per_cu);
        fprintf(stderr, "kernel_launch: grid %d (cus %d, per_cu %d)\n", grid, cus, per_cu);
    }
    if (grid < 0) return;
    Params p{};
    for (int i = 0; i < 24; ++i) p.in[i] = (const float*)d_in[i];
    p.out = (float*)d_out; p.ws = (unsigned char*)d_ws;
    if (hipMemsetAsync((char*)d_ws + WS_CTL, 0, CTL_BYTES, stream) != hipSuccess) { fprintf(stderr, "kernel_launch: memset failed\n"); return; }
    void* args[] = {&p};
    hipError_t e = hipLaunchCooperativeKernel((const void*)fwd_kernel, dim3(grid), dim3(NTHREADS), args, LDS_BYTES, stream);
    if (e != hipSuccess) fprintf(stderr, "cooperative launch failed: %s (grid %d)\n", hipGetErrorString(e), grid);
}
```
